# Optimizing an MI355X kernel written in HIP

```python
import math
import jax, jax.numpy as jnp
from jax import lax
import numpy as np


D_MODEL = 2048
BATCH = 8
SEQ = 2048
DEPTH = 1

HEAD_DIM = 128
DIL_CONFIGS = ((128, 1), (512, 4), (2048, 16))
N_DIL_GROUPS = 3
HEADS_PER_DIL_GROUP = 4
HEADS_A = N_DIL_GROUPS * HEADS_PER_DIL_GROUP
N_KEYS_A = 129
HEADS_B = 8
N_ATTN_HEADS = HEADS_A + HEADS_B
IDX_HEADS = 16
IDX_DIM = 64
TOPK_MAX = 256
N_BUCKETS = 32
MAX_DISTANCE = 2048
D_FF = 4 * D_MODEL
WIDTH_A = HEADS_A * HEAD_DIM
WIDTH_B = HEADS_B * HEAD_DIM
WIDTH_A_OUT = HEADS_PER_DIL_GROUP * HEAD_DIM
D_IN = 3 * WIDTH_A + 3 * WIDTH_B + IDX_HEADS * IDX_DIM + IDX_DIM + IDX_HEADS + 2 * D_MODEL
Q_BLOCK = 64
NORM_EPS = 1e-6
NEG_INF = -1e30

kernel_name = "gated_dilated_dsa_hybrid_block"


def rms_norm(x, g):
    xf = x.astype(jnp.float32)
    y = xf * lax.rsqrt(jnp.mean(xf * xf, axis=-1, keepdims=True) + NORM_EPS) * g.astype(jnp.float32)
    return y.astype(x.dtype)


def layer_norm(x, g, b):
    xf = x.astype(jnp.float32)
    mu = jnp.mean(xf, axis=-1, keepdims=True)
    var = jnp.mean(jnp.square(xf - mu), axis=-1, keepdims=True)
    y = (xf - mu) * lax.rsqrt(var + NORM_EPS) * g.astype(jnp.float32) + b.astype(jnp.float32)
    return y.astype(x.dtype)


def t5_bucket(dist):
    n = jnp.maximum(dist, 0)
    max_exact = N_BUCKETS // 2
    nf = jnp.maximum(n, 1).astype(jnp.float32)
    large = max_exact + (jnp.log(nf / max_exact) / math.log(MAX_DISTANCE / max_exact)
                         * (N_BUCKETS - max_exact)).astype(jnp.int32)
    large = jnp.minimum(large, N_BUCKETS - 1)
    return jnp.where(n < max_exact, n, large)


def dilation_offsets():
    return jnp.asarray(np.stack([dil * np.arange(N_KEYS_A) for _, dil in DIL_CONFIGS]), dtype=jnp.int32)


def dilated_mixture_attention(q, k, v, bias_a):
    b, s = q.shape[:2]
    dist = dilation_offsets()
    g_idx = jnp.arange(N_DIL_GROUPS)[:, None, None]
    scale = HEAD_DIM ** -0.5

    def block(i):
        t = i * Q_BLOCK + jnp.arange(Q_BLOCK)
        key_pos = t[None, :, None] - dist[:, None, :]
        valid = key_pos >= 0
        kp = jnp.maximum(key_pos, 0)
        qb = lax.dynamic_slice_in_dim(q, i * Q_BLOCK, Q_BLOCK, axis=1)
        kg = k[:, kp, g_idx]
        vg = v[:, kp, g_idx]
        logits = jnp.einsum('bqghd,bgqjhd->bgqhj', qb, kg,
                            preferred_element_type=jnp.float32) * scale + bias_a[None, :, None]
        logits = jnp.where(valid[None, :, :, None, :], logits, NEG_INF)
        m = jnp.max(logits, axis=-1, keepdims=True)
        e = jnp.exp(logits - m)
        den = jnp.sum(e, axis=-1)
        o = jnp.einsum('bgqhj,bgqjhd->bgqhd', e, vg.astype(jnp.float32)) / den[..., None]
        lse = m[..., 0] + jnp.log(den)
        wts = jax.nn.softmax(lse, axis=1)
        return jnp.einsum('bgqh,bgqhd->bqhd', wts, o)

    out = lax.map(block, jnp.arange(s // Q_BLOCK))
    return out.transpose(1, 0, 2, 3, 4).reshape(b, s, HEADS_PER_DIL_GROUP, HEAD_DIM).astype(q.dtype)


def indexed_sparse_attention(q, k, v, q_idx, k_idx, w_idx, bias_b):
    b, s = q.shape[:2]
    topk = min(TOPK_MAX, s // 4)
    s_pos = jnp.arange(s)
    scale = HEAD_DIM ** -0.5
    idx_scale = IDX_DIM ** -0.5

    def block(i):
        t = i * Q_BLOCK + jnp.arange(Q_BLOCK)
        qi = lax.dynamic_slice_in_dim(q_idx, i * Q_BLOCK, Q_BLOCK, axis=1)
        wi = lax.dynamic_slice_in_dim(w_idx, i * Q_BLOCK, Q_BLOCK, axis=1)
        qb = lax.dynamic_slice_in_dim(q, i * Q_BLOCK, Q_BLOCK, axis=1)
        rel = jax.nn.relu(jnp.einsum('bqhd,bsd->bqsh', qi, k_idx,
                                     preferred_element_type=jnp.float32) * idx_scale)
        score = jnp.einsum('bqsh,bqh->bqs', rel, wi.astype(jnp.float32))
        causal = s_pos[None, :] <= t[:, None]
        score = jnp.where(causal[None], score, NEG_INF)
        _, sel = lax.top_k(score, topk)
        valid = sel <= t[None, :, None]
        kg = jax.vmap(lambda kk, ii: kk[ii])(k, sel)
        vg = jax.vmap(lambda vv, ii: vv[ii])(v, sel)
        logits = jnp.einsum('bqhd,bqkhd->bqkh', qb, kg, preferred_element_type=jnp.float32) * scale
        logits = logits + bias_b[t5_bucket(t[None, :, None] - sel)].astype(jnp.float32)
        logits = jnp.where(valid[..., None], logits, NEG_INF)
        p = jax.nn.softmax(logits, axis=2)
        return jnp.einsum('bqkh,bqkhd->bqhd', p, vg.astype(jnp.float32))

    out = lax.map(block, jnp.arange(s // Q_BLOCK))
    return out.transpose(1, 0, 2, 3, 4).reshape(b, s, HEADS_B, HEAD_DIM).astype(q.dtype)


def split_columns(proj):
    sizes = (3 * WIDTH_A, 3 * WIDTH_B, IDX_HEADS * IDX_DIM, IDX_DIM, IDX_HEADS, D_MODEL, D_MODEL)
    offs = np.cumsum(sizes)[:-1].tolist()
    return jnp.split(proj, offs, axis=-1)


def setup_inputs(seed: int = 0) -> dict:
    key = jax.random.key(seed)
    ks = jax.random.split(key, 14)
    f32 = jnp.float32
    nrm = lambda k, shape: jax.random.normal(k, shape, f32)
    return {
        "x": nrm(ks[0], (BATCH, SEQ, D_MODEL)),
        "norm_mix_g": 1.0 + 0.05 * nrm(ks[1], (DEPTH, D_MODEL)),
        "w_in": nrm(ks[2], (DEPTH, D_MODEL, D_IN)) * D_MODEL ** -0.5,
        "idx_k_norm_g": 1.0 + 0.05 * nrm(ks[3], (DEPTH, IDX_DIM)),
        "idx_k_norm_b": 0.01 * nrm(ks[4], (DEPTH, IDX_DIM)),
        "rel_bias_table": 0.5 * nrm(ks[5], (N_BUCKETS, N_ATTN_HEADS)),
        "w_proj_a": nrm(ks[6], (DEPTH, WIDTH_A_OUT, D_MODEL)) * WIDTH_A_OUT ** -0.5,
        "w_proj_b": nrm(ks[7], (DEPTH, WIDTH_B, D_MODEL)) * WIDTH_B ** -0.5,
        "w_out": nrm(ks[8], (DEPTH, D_MODEL, D_MODEL)) * D_MODEL ** -0.5,
        "norm_mlp_g": 1.0 + 0.05 * nrm(ks[9], (DEPTH, D_MODEL)),
        "w_mlp_up": nrm(ks[10], (DEPTH, D_MODEL, D_FF)) * D_MODEL ** -0.5,
        "w_mlp_down": nrm(ks[11], (DEPTH, D_FF, D_MODEL)) * D_FF ** -0.5,
        "norm_final_g": 1.0 + 0.05 * nrm(ks[12], (D_MODEL,)),
    }


def reference(x, norm_mix_g, w_in, idx_k_norm_g, idx_k_norm_b, rel_bias_table, w_proj_a, w_proj_b,
              w_out, norm_mlp_g, w_mlp_up, w_mlp_down, norm_final_g):
    b, s, _ = x.shape
    head_ids_a = jnp.arange(HEADS_A).reshape(N_DIL_GROUPS, HEADS_PER_DIL_GROUP)
    buckets_a = t5_bucket(dilation_offsets())
    bias_a = rel_bias_table[buckets_a[:, :, None], head_ids_a[:, None, :]]
    bias_a = bias_a.transpose(0, 2, 1).astype(jnp.float32)
    bias_b = rel_bias_table[:, HEADS_A:]

    for layer in range(DEPTH):
        h = rms_norm(x, norm_mix_g[layer])
        qkv_a, qkv_b, q_idx, k_idx, w_idx, gate_a, gate_b = split_columns(h @ w_in[layer])
        qkv_a = qkv_a.reshape(b, s, 3, N_DIL_GROUPS, HEADS_PER_DIL_GROUP, HEAD_DIM)
        qkv_b = qkv_b.reshape(b, s, 3, HEADS_B, HEAD_DIM)
        o_a = dilated_mixture_attention(qkv_a[:, :, 0], qkv_a[:, :, 1], qkv_a[:, :, 2], bias_a)
        q_idx = q_idx.reshape(b, s, IDX_HEADS, IDX_DIM)
        k_idx = layer_norm(k_idx, idx_k_norm_g[layer], idx_k_norm_b[layer])
        w_idx = w_idx * IDX_HEADS ** -0.5
        o_b = indexed_sparse_attention(qkv_b[:, :, 0], qkv_b[:, :, 1], qkv_b[:, :, 2],
                                       q_idx, k_idx, w_idx, bias_b)
        merged = (jax.nn.sigmoid(gate_a) * (o_a.reshape(b, s, WIDTH_A_OUT) @ w_proj_a[layer])
                  + jax.nn.sigmoid(gate_b) * (o_b.reshape(b, s, WIDTH_B) @ w_proj_b[layer]))
        x = x + merged @ w_out[layer]
        hm = rms_norm(x, norm_mlp_g[layer])
        x = x + jnp.square(jax.nn.relu(hm @ w_mlp_up[layer])) @ w_mlp_down[layer]
    return rms_norm(x, norm_final_g)
```

```cpp
#include <hip/hip_runtime.h>
#include <cstdio>
#include <cstdint>
#include <cfloat>
namespace pg8 {
#define PG8_LAS __attribute__((address_space(3)))
typedef unsigned short bf16_t;
typedef short bf16x8 __attribute__((ext_vector_type(8)));
typedef float f32x4 __attribute__((ext_vector_type(4)));
typedef unsigned u32x4 __attribute__((ext_vector_type(4)));
typedef int i32x8 __attribute__((ext_vector_type(8)));
typedef int i32x4 __attribute__((ext_vector_type(4)));
__device__ __forceinline__ i32x8 f8cat(bf16x8 lo, bf16x8 hi) { const i32x4 a = __builtin_bit_cast(i32x4, lo), b = __builtin_bit_cast(i32x4, hi); return __builtin_shufflevector(a, b, 0, 1, 2, 3, 4, 5, 6, 7); }
constexpr int BM = 256, BK = 64, HALF = 128, HTB = HALF * BK * 2  , STAGE_BYTES = 8 * HTB, NXCD = 8, WGM = 8;

__host__ __device__ __forceinline__ int lds_byte(int r, int c) { const int st = (r >> 4) * 2 + (c >> 5), rr = r & 15, cc = c & 31, ob = rr * 64 + cc * 2; return st * 1024 + (ob ^ (((ob >> 9) & 1) << 5)); }
__host__ __device__ __forceinline__ void stage_rc(int b, int& R, int& C) { const int st = b / 1024, sb = b % 1024, swz = sb ^ (((sb >> 9) & 1) << 5); R = (st >> 1) * 16 + swz / 64; C = (st & 1) * 32 + (swz % 64) / 2; }
__host__ __device__ __forceinline__ int perm32(int rho) { const int n = rho >> 4, i = rho & 15; return 8 * (i >> 2) + 4 * n + (i & 3); }

struct Unit { int pm, pn, ui; };
struct Gemm { const bf16_t* A; const bf16_t* Bt; int M, N, K; };

struct StaticOrder {
    int nM, nN, nwg, G, c;
    __host__ __device__ void init(int M, int N, int G_, int c_) { nM = M / BM; nN = N / BM; nwg = nM * nN; G = G_; c = c_; }
    __host__ __device__ bool next(int i, Unit& u) const {
        const long L = (long)i * G + c; if (L >= nwg) return false;
        int wgid = (int)L; { const int q = nwg / NXCD, r = nwg % NXCD, xcd = wgid % NXCD, off = wgid / NXCD; wgid = (xcd < r ? xcd * (q + 1) : r * (q + 1) + (xcd - r) * q) + off; }
        const int nig = WGM * nN, gid = wgid / nig, fm = gid * WGM, gsz = (nM - fm) < WGM ? (nM - fm) : WGM;
        u.pm = fm + ((wgid % nig) % gsz); u.pn = (wgid % nig) / gsz; return true;
    }
    __device__ __forceinline__ void a_ready(const Unit&) const {}
    __device__ __forceinline__ void done(const Unit&) const {}
};
template <int NN>
struct DenseOrder {
    static constexpr int TG = NN / 8, PG = 8 / TG, PPR = 4 * PG;
    int pm_lo, npm, G, c, desc;
    __host__ __device__ void init(int pm_lo_, int npm_, int G_, int c_, int desc_) { pm_lo = pm_lo_; npm = npm_; G = G_; c = c_; desc = desc_; }
    __host__ __device__ bool next(int i, Unit& u) const {
        if (G != 256 || npm % PPR) { const long L = (long)i * G + c; if (L >= (long)npm * NN) return false; u.pm = pm_lo + (int)(L / NN); u.pn = (int)(L % NN); return true; }
        if (i * PPR >= npm) return false;
        const int x = c & 7, s = c >> 3, r = desc ? npm / PPR - 1 - i : i;
        u.pm = pm_lo + r * PPR + (x % PG) * 4 + (s >> 3); u.pn = (x / PG) * 8 + (s & 7); return true;
    }
    __device__ __forceinline__ void a_ready(const Unit&) const {}
    __device__ __forceinline__ void done(const Unit&) const {}
};
struct QkvOrder {
    int G, c;
    __host__ __device__ void init(int G_, int c_) { G = G_; c = c_; }
    __host__ __device__ bool next(int i, Unit& u) const {
        if (G != 256) { const long L = (long)i * G + c; if (L >= 64L * 30) return false; u.pm = (int)(L / 30); u.pn = (int)(L % 30); return true; }
        const int x = c & 7, s = c >> 3; if (s >= 30 || i >= 8) return false;
        u.pm = 8 * i + 2 * (x & 3) + s / 15; u.pn = 15 * (x >> 2) + s % 15; return true;
    }
    __device__ __forceinline__ void a_ready(const Unit&) const {}
    __device__ __forceinline__ void done(const Unit&) const {}
};
struct IdxOrder {
    int G, c;
    __host__ __device__ void init(int G_, int c_) { G = G_; c = c_; }
    __host__ __device__ bool next(int i, Unit& u) const {
        if (G != 256) { const long L = (long)i * G + c; if (L >= 64L * 5) return false; u.pm = (int)(L / 5); u.pn = (int)(L % 5); return true; }
        const int x = c & 7, s = c >> 3; int q;
        if (s >= 30) { if (i >= 5) return false; q = i * 16 + x * 2 + (s - 30); } else { if (i >= 1) return false; q = 80 + x * 30 + s; }
        u.pm = q / 5; u.pn = q % 5; return true;
    }
    __device__ __forceinline__ void a_ready(const Unit&) const {}
    __device__ __forceinline__ void done(const Unit&) const {}
};
struct WeightStationaryOrder {
    int G, c, desc;
    __host__ __device__ void init(int G_, int c_, int desc_) { G = G_; c = c_; desc = desc_; }
    __host__ __device__ bool next(int i, Unit& u) const {
        if (G != 256) { const long L = (long)i * G + c; if (L >= 64L * 32) return false; u.pm = (int)(L / 32); u.pn = (int)(L % 32); return true; }
        if (i >= 8) return false;
        const int x = c & 7, s = c >> 3, r = desc ? 7 - i : i; u.pm = r * 8 + (s >> 2); u.pn = x * 4 + (s & 3); return true;
    }
    __device__ __forceinline__ void a_ready(const Unit&) const {}
    __device__ __forceinline__ void done(const Unit&) const {}
};
struct RowPanelOrder {
    int nM, nN, G, v;
    __host__ __device__ void init(int M, int N, int G_, int v_) { nM = M / BM; nN = N / BM; G = G_; v = v_; }
    __host__ __device__ bool next(int i, Unit& u) const {
        if (G != 4 * nM || (nN & 3)) { const long L = (long)i * G + v; if (L >= (long)nM * nN) return false; u.pm = (int)(L / nN); u.pn = (int)(L % nN); return true; }
        const int per = nN >> 2; if (i >= per) return false; u.pm = v >> 2; u.pn = (v & 3) * per + i; return true;
    }
    __device__ __forceinline__ void a_ready(const Unit&) const {}
    __device__ __forceinline__ void done(const Unit&) const {}
};
struct BalancedOrder {
    StaticOrder base; int full, split, tail_per; bool low;
    __host__ __device__ void init(int M, int N, int G_, int c_, int full_, int split_, int tail_per_, bool low_) { base.init(M, N, G_, c_); full = full_; split = split_; tail_per = tail_per_; low = low_; }
    __host__ __device__ bool next(int i, Unit& u) const {
        if (i < full) return base.next(i, u);
        const int j = i - full; if (j >= tail_per) return false;
        const int c = base.c, G = base.G; int idx;
        if (low) { if (c >= split) return false; idx = j * split + c; } else { if (c < split) return false; idx = j * (G - split) + (c - split); }
        StaticOrder t = base; t.c = 0; t.G = 1;
        return t.next(full * G + idx, u);
    }
    __device__ __forceinline__ void a_ready(const Unit&) const {}
    __device__ __forceinline__ void done(const Unit&) const {}
};

__device__ __forceinline__ unsigned cvt_pk_bf16(float lo, float hi) { unsigned r; asm volatile("v_cvt_pk_bf16_f32 %0, %1, %2" : "=v"(r) : "v"(lo), "v"(hi)); return r; }
__device__ __forceinline__ u32x4 pack8(const f32x4 a, const f32x4 b) { u32x4 w; w.x = cvt_pk_bf16(a[0], a[1]); w.y = cvt_pk_bf16(a[2], a[3]); w.z = cvt_pk_bf16(b[0], b[1]); w.w = cvt_pk_bf16(b[2], b[3]); return w; }
__device__ __forceinline__ void unpack8(const u32x4 w, f32x4& a, f32x4& b) {
    a[0] = __uint_as_float(w.x << 16); a[1] = __uint_as_float(w.x & 0xffff0000u); a[2] = __uint_as_float(w.y << 16); a[3] = __uint_as_float(w.y & 0xffff0000u);
    b[0] = __uint_as_float(w.z << 16); b[1] = __uint_as_float(w.z & 0xffff0000u); b[2] = __uint_as_float(w.w << 16); b[3] = __uint_as_float(w.w & 0xffff0000u); }
__device__ __forceinline__ unsigned pk4_fp8(float a, float b, float c, float d) { int v = 0; v = __builtin_amdgcn_cvt_pk_fp8_f32(a, b, v, false); v = __builtin_amdgcn_cvt_pk_fp8_f32(c, d, v, true); return (unsigned)v; }
__device__ __forceinline__ float sigmoidf_(float x) { return __builtin_amdgcn_rcpf(1.0f + __builtin_amdgcn_exp2f(-1.4426950408889634f * x)); }

__device__ __forceinline__ void row_scalars(const float* p, int row0, float (&rs)[2][4]) {
#pragma unroll
    for (int ai = 0; ai < 2; ++ai)
#pragma unroll
        for (int m = 0; m < 4; ++m) rs[ai][m] = p[row0 + ai * HALF + m * 16];
    asm volatile("" : "+v"(rs[0][0]), "+v"(rs[0][1]), "+v"(rs[0][2]), "+v"(rs[0][3]), "+v"(rs[1][0]), "+v"(rs[1][1]), "+v"(rs[1][2]), "+v"(rs[1][3]) :: "memory");
}
constexpr float QKB_PRESCALE = 0.088388347648318440f * 1.4426950408889634f;
struct EpiQKV {
    static constexpr bool PERM = true, AFTER_DRAIN = false; static constexpr int HOOK_T = -1;
    float asc  ; bf16_t* QV; bf16_t* KAF; size_t kbf_delta  ; const float* rstd0;
    __device__ __forceinline__ void hook(f32x4 (&)[2][2][4][2], const Unit&, int, int, int, int) const {}
    __device__ __forceinline__ void operator()(const f32x4 (&acc)[2][2][4][2], const Unit& u, int wr, int wc, int fr, int fq) const {
        const int row0 = u.pm * BM + wr * 64 + fr, pn = u.pn;
        float rsv[2][4]; row_scalars(rstd0, row0, rsv);
        const bool is_ka = (pn >= 6 && pn < 12), is_kb = (pn >= 22 && pn < 26);
        if (is_ka || is_kb) {
            const int d0 = 2 * wc + (fq >> 1), hi = fq & 1;
#pragma unroll
            for (int ai = 0; ai < 2; ++ai)
#pragma unroll
                for (int m = 0; m < 4; ++m) { const int row = row0 + ai * HALF + m * 16; const float rs = rsv[ai][m] * asc; const int b = row >> 11, t = row & 2047;
#pragma unroll
                    for (int bj = 0; bj < 2; ++bj) { size_t off;
                        if (is_kb) { const int head = 2 * pn + bj - 44; off = ((size_t)(((b * 8 + head) * 64 + (t >> 5)) * 8 + d0)) * 512 + ((t & 31) + 32 * hi) * 8; }
                        else { const int gh = 2 * pn + bj - 12, g = gh >> 2, dsh = 2 * g, r = t & ((1 << dsh) - 1), p = t >> dsh;
                               off = ((size_t)((((b * 3 + g) * 4 + (gh & 3)) * 64 + r * (64 >> dsh) + (p >> 5)) * 8 + d0)) * 512 + ((p & 31) + 32 * hi) * 8; }
                        if (is_kb) off += kbf_delta;
                        *(u32x4*)(KAF + off) = pack8(acc[ai][bj][m][0] * rs, acc[ai][bj][m][1] * rs); } }
        } else {
            const int col0 = (pn < 6 ? pn : pn < 22 ? pn - 6 : pn - 10) * BM + wc * 32 + 8 * fq;
            const float qsc = (pn < 6 || (pn >= 18 && pn < 22)) ? QKB_PRESCALE : 1.0f;
#pragma unroll
            for (int ai = 0; ai < 2; ++ai)
#pragma unroll
                for (int m = 0; m < 4; ++m) { const int row = row0 + ai * HALF + m * 16; const float rs = rsv[ai][m] * asc * qsc; bf16_t* rowp = QV + (size_t)row * 5120 + col0;
#pragma unroll
                    for (int bj = 0; bj < 2; ++bj) *(u32x4*)(rowp + bj * HALF) = pack8(acc[ai][bj][m][0] * rs, acc[ai][bj][m][1] * rs); }
        }
    }
};
template <size_t O_QI, size_t O_KI, size_t O_WI, size_t O_RSTD> struct EpiIdx {
    static constexpr bool PERM = true, AFTER_DRAIN = false; static constexpr int HOOK_T = -1;
    unsigned char* ws; const float* lng; const float* lnb;
    __device__ __forceinline__ void hook(f32x4 (&)[2][2][4][2], const Unit&, int, int, int, int) const {}
    __device__ __forceinline__ void operator()(const f32x4 (&acc)[2][2][4][2], const Unit& u, int wr, int wc, int fr, int fq) const {
        bf16_t* QI = (bf16_t*)(ws + O_QI); bf16_t* KI = (bf16_t*)(ws + O_KI); float* WI = (float*)(ws + O_WI); const float* rstd0 = (const float*)(ws + O_RSTD);
        const int row0 = u.pm * BM + wr * 64 + fr, pn = u.pn + 30; const float asc = 1.0f;
        float rsv[2][4]; row_scalars(rstd0, row0, rsv);
        if (pn < 34) {
            bf16_t* base = QI; const int ldc = 1024, colt = (pn - 30) * BM; const float sc = 0.125f;
            const int col0 = colt + wc * 32 + 8 * fq;
#pragma unroll
            for (int ai = 0; ai < 2; ++ai)
#pragma unroll
                for (int m = 0; m < 4; ++m) { const int row = row0 + ai * HALF + m * 16; const float rs = rsv[ai][m] * sc; bf16_t* rowp = base + (size_t)row * ldc + col0;
#pragma unroll
                    for (int bj = 0; bj < 2; ++bj) *(u32x4*)(rowp + bj * HALF) = pack8(acc[ai][bj][m][0] * rs, acc[ai][bj][m][1] * rs); }
        } else if (wc == 0) {
            f32x4 g0[2], g1[2], b0[2], b1[2];
#pragma unroll
            for (int n = 0; n < 2; ++n) { g0[n] = *(const f32x4*)(lng + 8 * fq + 4 * n); g1[n] = *(const f32x4*)(lng + 32 + 8 * fq + 4 * n); b0[n] = *(const f32x4*)(lnb + 8 * fq + 4 * n); b1[n] = *(const f32x4*)(lnb + 32 + 8 * fq + 4 * n); }
#pragma unroll
            for (int ai = 0; ai < 2; ++ai)
#pragma unroll
                for (int m = 0; m < 4; ++m) { const int row = row0 + ai * HALF + m * 16; const float rs = rsv[ai][m] * asc;
                    f32x4 v[2][2]; float s = 0.f;
#pragma unroll
                    for (int bj = 0; bj < 2; ++bj)
#pragma unroll
                        for (int n = 0; n < 2; ++n) { v[bj][n] = acc[ai][bj][m][n] * rs; s += (v[bj][n][0] + v[bj][n][1]) + (v[bj][n][2] + v[bj][n][3]); }
                    s += __shfl_xor(s, 16); s += __shfl_xor(s, 32);
                    const float mean = s * (1.0f / 64.0f); float q = 0.f;
#pragma unroll
                    for (int bj = 0; bj < 2; ++bj)
#pragma unroll
                        for (int n = 0; n < 2; ++n) { v[bj][n] = v[bj][n] - mean; q += (v[bj][n][0] * v[bj][n][0] + v[bj][n][1] * v[bj][n][1]) + (v[bj][n][2] * v[bj][n][2] + v[bj][n][3] * v[bj][n][3]); }
                    q += __shfl_xor(q, 16); q += __shfl_xor(q, 32);
                    const float rstd = 1.0f / sqrtf(q * (1.0f / 64.0f) + 1e-6f);
                    bf16_t* rowp = KI + (size_t)(row >> 5) * 2048 + (fq >> 1) * 512 + ((row & 31) + 32 * (fq & 1)) * 8;
                    *(u32x4*)(rowp) = pack8(v[0][0] * rstd * g0[0] + b0[0], v[0][1] * rstd * g0[1] + b0[1]);
                    *(u32x4*)(rowp + 1024) = pack8(v[1][0] * rstd * g1[0] + b1[0], v[1][1] * rstd * g1[1] + b1[1]); }
        } else if (wc == 1) {
            if (fq < 2) {
#pragma unroll
                for (int ai = 0; ai < 2; ++ai)
#pragma unroll
                    for (int m = 0; m < 4; ++m) { const int row = row0 + ai * HALF + m * 16; const float rs = rsv[ai][m] * 0.25f * asc; float* rowp = WI + (size_t)row * 16 + 8 * fq;
                        *(f32x4*)(rowp) = acc[ai][0][m][0] * rs; *(f32x4*)(rowp + 4) = acc[ai][0][m][1] * rs; }
            }
        }
    }
};
struct EpiGate {
    static constexpr bool PERM = true, AFTER_DRAIN = false; static constexpr int HOOK_T = -1;
    bf16_t* R; bf16_t* SB; long r_hi, sb_hi  ; const float* rstd0; float asc;
    __device__ __forceinline__ void hook(f32x4 (&)[2][2][4][2], const Unit&, int, int, int, int) const {}
    __device__ __forceinline__ void operator()(const f32x4 (&acc)[2][2][4][2], const Unit& u, int wr, int wc, int fr, int fq) const {
        const int row0 = u.pm * BM + wr * 64 + fr, col0 = u.pn * HALF + wc * 32 + 8 * fq;
        float rsv[2][4]; row_scalars(rstd0, row0, rsv);
        bf16_t* Rb = R + (u.pm >= 32 ? r_hi : 0L); bf16_t* Sb = SB + (u.pm >= 32 ? sb_hi : 0L);
#pragma unroll
        for (int ai = 0; ai < 2; ++ai)
#pragma unroll
            for (int m = 0; m < 4; ++m) { const int row = row0 + ai * HALF + m * 16; const float rs = rsv[ai][m] * asc; const size_t off = (size_t)row * 2048 + col0;
                f32x4 r0, r1, s0, s1;
                const float nrs = -1.4426950408889634f * rs;
#pragma unroll
                for (int j = 0; j < 4; ++j) { const float da0 = 1.0f + __builtin_amdgcn_exp2f(acc[ai][0][m][0][j] * nrs), da1 = 1.0f + __builtin_amdgcn_exp2f(acc[ai][0][m][1][j] * nrs);
                    const float db0 = 1.0f + fminf(__builtin_amdgcn_exp2f(acc[ai][1][m][0][j] * nrs), 1e20f), db1 = 1.0f + fminf(__builtin_amdgcn_exp2f(acc[ai][1][m][1][j] * nrs), 1e20f);
                    s0[j] = __builtin_amdgcn_rcpf(db0); s1[j] = __builtin_amdgcn_rcpf(db1);
                    r0[j] = db0 * __builtin_amdgcn_rcpf(da0); r1[j] = db1 * __builtin_amdgcn_rcpf(da1); }
                *(u32x4*)(Rb + off) = pack8(r0, r1); *(u32x4*)(Sb + off) = pack8(s0, s1); }
    }
};
template <int HT> struct EpiMerged {
    static constexpr bool PERM = true, AFTER_DRAIN = false; static constexpr int HOOK_T = HT;
    unsigned char* MG; const bf16_t* R; const bf16_t* SB; long r_hi, sb_hi  ; float osc;
    __device__ __forceinline__ void hook(f32x4 (&acc)[2][2][4][2], const Unit& u, int wr, int wc, int fr, int fq) const {
        unsigned o0 = (unsigned)(u.pm * BM + wr * 64 + fr) * 2048u + (unsigned)(u.pn * BM + wc * 32 + 8 * fq); asm volatile("" : "+v"(o0));
        const bf16_t* Rb = R + (u.pm >= 32 ? r_hi : 0L);
        u32x4 w[2][4][2];
#pragma unroll
        for (int ai = 0; ai < 2; ++ai)
#pragma unroll
            for (int m = 0; m < 4; ++m)
#pragma unroll
                for (int bj = 0; bj < 2; ++bj) w[ai][m][bj] = *(const u32x4*)(Rb + o0 + (unsigned)((ai * HALF + m * 16) * 2048) + bj * HALF);
#pragma unroll
        for (int ai = 0; ai < 2; ++ai)
#pragma unroll
            for (int m = 0; m < 4; ++m)
#pragma unroll
                for (int bj = 0; bj < 2; ++bj) { f32x4 a0, a1; unpack8(w[ai][m][bj], a0, a1); acc[ai][bj][m][0] *= a0; acc[ai][bj][m][1] *= a1; }
    }
    __device__ __forceinline__ void operator()(const f32x4 (&acc)[2][2][4][2], const Unit& u, int wr, int wc, int fr, int fq) const {
        unsigned o0 = (unsigned)(u.pm * BM + wr * 64 + fr) * 2048u + (unsigned)(u.pn * BM + wc * 32 + 8 * fq); asm volatile("" : "+v"(o0));
        const bf16_t* Sb = SB + (u.pm >= 32 ? sb_hi : 0L);
        u32x4 w[2][4][2];
#pragma unroll
        for (int ai = 0; ai < 2; ++ai)
#pragma unroll
            for (int m = 0; m < 4; ++m)
#pragma unroll
                for (int bj = 0; bj < 2; ++bj) w[ai][m][bj] = *(const u32x4*)(Sb + o0 + (unsigned)((ai * HALF + m * 16) * 2048) + bj * HALF);
        asm volatile("" ::: "memory");
#pragma unroll
        for (int ai = 0; ai < 2; ++ai)
#pragma unroll
            for (int m = 0; m < 4; ++m) { const unsigned o = o0 + (unsigned)((ai * HALF + m * 16) * 2048);
#pragma unroll
                for (int bj = 0; bj < 2; ++bj) { f32x4 b0, b1; unpack8(w[ai][m][bj], b0, b1);
                    const f32x4 v0 = acc[ai][bj][m][0] * b0 * osc, v1 = acc[ai][bj][m][1] * b1 * osc; typedef unsigned u32x2 __attribute__((ext_vector_type(2)));
                    *(u32x2*)(MG + o + bj * HALF) = (u32x2){pk4_fp8(v0[0], v0[1], v0[2], v0[3]), pk4_fp8(v1[0], v1[1], v1[2], v1[3])}; } }
    }
};
struct EpiResid {
    static constexpr bool PERM = true, AFTER_DRAIN = false; static constexpr int HOOK_T = -1;
    bf16_t* resb; float* ss; float asc;
    __device__ __forceinline__ void hook(f32x4 (&)[2][2][4][2], const Unit&, int, int, int, int) const {}
    __device__ __forceinline__ void operator()(const f32x4 (&acc)[2][2][4][2], const Unit& u, int wr, int wc, int fr, int fq) const {
        const int row0 = u.pm * BM + wr * 64 + fr;
        unsigned o0 = (unsigned)row0 * 2048u + (unsigned)(u.pn * BM + wc * 32 + 8 * fq); asm volatile("" : "+v"(o0));
        float sq[2][4];
        u32x4 rb[2][4][2];
#pragma unroll
        for (int ai = 0; ai < 2; ++ai)
#pragma unroll
            for (int m = 0; m < 4; ++m)
#pragma unroll
                for (int bj = 0; bj < 2; ++bj) rb[ai][m][bj] = *(const u32x4*)(resb + o0 + (unsigned)((ai * HALF + m * 16) * 2048) + bj * HALF);
        asm volatile("" ::: "memory");
#pragma unroll
        for (int ai = 0; ai < 2; ++ai)
#pragma unroll
            for (int m = 0; m < 4; ++m) { const unsigned o = o0 + (unsigned)((ai * HALF + m * 16) * 2048); float s = 0.f;
#pragma unroll
                for (int bj = 0; bj < 2; ++bj) { f32x4 r0, r1; unpack8(rb[ai][m][bj], r0, r1); const f32x4 v0 = r0 + acc[ai][bj][m][0] * asc, v1 = r1 + acc[ai][bj][m][1] * asc;
                    *(u32x4*)(resb + o + bj * HALF) = pack8(v0, v1);
                    s += (v0[0] * v0[0] + v0[1] * v0[1]) + (v0[2] * v0[2] + v0[3] * v0[3]) + (v1[0] * v1[0] + v1[1] * v1[1]) + (v1[2] * v1[2] + v1[3] * v1[3]); }
                s += __shfl_xor(s, 16); s += __shfl_xor(s, 32); sq[ai][m] = s; }
#pragma unroll
        for (int ai = 0; ai < 2; ++ai)
#pragma unroll
            for (int m = 0; m < 4; ++m) if (fq == 0) unsafeAtomicAdd(ss + row0 + ai * HALF + m * 16, sq[ai][m]);
    }
};
struct EpiUp {
    static constexpr bool PERM = true, AFTER_DRAIN = false; static constexpr int HOOK_T = -1;
    bf16_t* H; const float* ss1;
    __device__ __forceinline__ void hook(f32x4 (&)[2][2][4][2], const Unit&, int, int, int, int) const {}
    __device__ __forceinline__ void operator()(const f32x4 (&acc)[2][2][4][2], const Unit& u, int wr, int wc, int fr, int fq) const {
        const int row0 = u.pm * BM + wr * 64 + fr;
        bf16_t* base = H + (size_t)u.pm * (BM * 8192) + (size_t)(u.pn * 4 + (wc >> 1)) * (BM * 64) + (unsigned)(wr * 8192 + (wc & 1) * 1024 + ((fr * 64 + 16 * fq) ^ ((fr >> 3) << 5))) / 2u;
        float rsv[2][4]; row_scalars(ss1, row0, rsv);
#pragma unroll
        for (int ai = 0; ai < 2; ++ai)
#pragma unroll
            for (int m = 0; m < 4; ++m) { const float r2 = 1.0f / (rsv[ai][m] * (1.0f / 2048.0f) + 1e-6f); bf16_t* rowp = base + ai * 8192 + m * 1024;
#pragma unroll
                for (int bj = 0; bj < 2; ++bj) { f32x4 v0 = acc[ai][bj][m][0], v1 = acc[ai][bj][m][1];
#pragma unroll
                    for (int j = 0; j < 4; ++j) { const float a = fmaxf(v0[j], 0.f), b = fmaxf(v1[j], 0.f); v0[j] = a * a * r2; v1[j] = b * b * r2; }
                    *(u32x4*)(rowp + bj * (2 * BM * 64)) = pack8(v0, v1); } }
    }
};
template <class Epi, class Sched, bool ALIGN_EPI = false, bool SP2 = false, bool FP8 = false, bool ATILED = false>
__device__ __forceinline__ void gemm_phase(PG8_LAS unsigned char* lds, const Gemm g, const Sched& S, const Epi& E) {
    int tid_o = threadIdx.x; asm volatile("" : "+v"(tid_o));
    const int tid = tid_o, wid = __builtin_amdgcn_readfirstlane(tid >> 6), lane = tid & 63, wr = wid >> 2, wc = wid & 3, fr = lane & 15, fq = lane >> 4;
    const int K = g.K, nt = K / BK;
    unsigned voffA[2], voffB[2];
#pragma unroll
    for (int i = 0; i < 2; ++i) { int R, C; stage_rc(tid * 16 + i * 8192, R, C); const int Rb = Epi::PERM ? ((R & ~31) + perm32(R & 31)) : R;
        voffA[i] = ATILED ? (unsigned)(tid * 16 + i * 8192) : (unsigned)(R * K + C) * 2u; voffB[i] = (unsigned)(Rb * K + C) * 2u; }
    const size_t kstep = (size_t)(BK * 2);
    const size_t hstep = (size_t)HALF * K * 2;
    const size_t tstep = 2 * hstep;
    const size_t kstepA = ATILED ? (size_t)(BM * BK * 2) : kstep, hstepA = ATILED ? (size_t)(HALF * BK * 2) : hstep, pstepA = ATILED ? (size_t)(64 * BK * 2) : (size_t)64 * K * 2;
    const unsigned ldsw = (unsigned)wid * 1024u;
    const int aoff = lds_byte(wr * 64 + fr, fq * 8), boff = lds_byte(wc * 32 + fr, fq * 8);
#define PG8_SA(b, h) (((b) * 2 + (h)) * HTB)
#define PG8_SB(b, h) ((4 + (b) * 2 + (h)) * HTB)
#define PG8_STAGEX(bufoff, gbase, voff, pstep) do { _Pragma("unroll") for (int _i = 0; _i < 2; ++_i) { unsigned vo_ = (voff)[0]; asm volatile("" : "+v"(vo_)); \
        __builtin_amdgcn_global_load_lds((const unsigned*)((const char*)(gbase) + (size_t)_i * (pstep) + vo_), (PG8_LAS unsigned*)(lds + (bufoff) + ldsw + _i * 8192), 16, 0, 0); } } while (0)
#define PG8_STAGE(bufoff, gbase, voff) PG8_STAGEX(bufoff, gbase, voff, (size_t)64 * K * 2)
#define PG8_STAGEA(bufoff, gbase, voff) PG8_STAGEX(bufoff, gbase, voff, pstepA)
#define PG8_LDA(dst, b, h) do { _Pragma("unroll") for (int m = 0; m < 4; ++m) _Pragma("unroll") for (int k = 0; k < 2; ++k) dst[m][k] = *(const PG8_LAS bf16x8*)(lds + PG8_SA(b, h) + aoff + m * 2048 + k * 1024); } while (0)
#define PG8_LDB(dst, b, h) do { _Pragma("unroll") for (int n = 0; n < 2; ++n) _Pragma("unroll") for (int k = 0; k < 2; ++k) dst[n][k] = *(const PG8_LAS bf16x8*)(lds + PG8_SB(b, h) + boff + n * 2048 + k * 1024); } while (0)
#define PG8_F8(X) f8cat((X)[0], (X)[1])
#define PG8_MMA(ai, bj, At, Bt) do { __builtin_amdgcn_s_setprio(1); _Pragma("unroll") for (int m = 0; m < 4; ++m) _Pragma("unroll") for (int n = 0; n < 2; ++n) { \
        if constexpr (FP8) acc[ai][bj][m][n] = __builtin_amdgcn_mfma_scale_f32_16x16x128_f8f6f4(PG8_F8(Bt[n]), PG8_F8(At[m]), acc[ai][bj][m][n], 0, 0, 0, 0, 0, 0); \
        else { _Pragma("unroll") for (int k = 0; k < 2; ++k) acc[ai][bj][m][n] = __builtin_amdgcn_mfma_f32_16x16x32_bf16(Bt[n][k], At[m][k], acc[ai][bj][m][n], 0, 0, 0); } } __builtin_amdgcn_s_setprio(0); } while (0)
#define PG8_WAIT_V(n) asm volatile("s_waitcnt vmcnt(" #n ")" ::: "memory")
#define PG8_WAIT_L(n) asm volatile("s_waitcnt lgkmcnt(" #n ")" ::: "memory")
#define PG8_BAR __builtin_amdgcn_s_barrier()
#define PG8_SCHED __builtin_amdgcn_sched_barrier(0)
    Unit cur, nxt; int ui = 0;
    if (!S.next(0, cur)) return;
    cur.ui = 0;
    f32x4 acc[2][2][4][2];
#pragma unroll
    for (int a = 0; a < 2; ++a)
#pragma unroll
        for (int b = 0; b < 2; ++b)
#pragma unroll
            for (int m = 0; m < 4; ++m)
#pragma unroll
                for (int n = 0; n < 2; ++n) acc[a][b][m][n] = (f32x4){0.f, 0.f, 0.f, 0.f};
    bf16x8 At[4][2], B0[2][2], B1[2][2];
    const char* cA = (const char*)g.A + (size_t)cur.pm * tstep; const char* cB = (const char*)g.Bt + (size_t)cur.pn * tstep;
    S.a_ready(cur);
    if constexpr (SP2) {
        PG8_STAGE(PG8_SB(0, 0), cB, voffB); PG8_STAGE(PG8_SB(0, 1), cB + hstep, voffB); PG8_STAGEA(PG8_SA(0, 0), cA, voffA); PG8_STAGEA(PG8_SA(0, 1), cA + hstepA, voffA);
        if (wr == 1) PG8_BAR;
        PG8_WAIT_V(2); PG8_BAR;
        PG8_STAGE(PG8_SB(1, 0), cB + kstep, voffB); PG8_STAGEA(PG8_SA(1, 0), cA + kstepA, voffA); PG8_STAGE(PG8_SB(1, 1), cB + hstep + kstep, voffB);
        PG8_WAIT_V(6); PG8_BAR;
    } else {
        PG8_STAGE(PG8_SB(0, 0), cB, voffB); PG8_STAGEA(PG8_SA(0, 0), cA, voffA); PG8_STAGE(PG8_SB(0, 1), cB + hstep, voffB); PG8_STAGEA(PG8_SA(0, 1), cA + hstepA, voffA);
        if (wr == 1) PG8_BAR;
        PG8_WAIT_V(4); PG8_BAR;
        PG8_STAGE(PG8_SB(1, 0), cB + kstep, voffB); PG8_STAGEA(PG8_SA(1, 0), cA + kstepA, voffA); PG8_STAGE(PG8_SB(1, 1), cB + hstep + kstep, voffB);
        PG8_WAIT_V(6); PG8_BAR;
    }
    for (;;) {
        const bool has_next = S.next(ui + 1, nxt); nxt.ui = ui + 1;
        const char* nA = has_next ? (const char*)g.A + (size_t)nxt.pm * tstep : cA; const char* nB = has_next ? (const char*)g.Bt + (size_t)nxt.pn * tstep : cB;
        constexpr int NSEG = (Epi::HOOK_T >= 0) ? 2 : 1;
#pragma unroll 1
        for (int seg = 0; seg < NSEG; ++seg) {
        const int t_lo = (seg == 0) ? 0 : Epi::HOOK_T, t_hi = (NSEG == 2 && seg == 0) ? Epi::HOOK_T : nt;
        if (seg == 1) { int t_o = threadIdx.x; asm volatile("" : "+v"(t_o)); E.hook(acc, cur, wr, wc, t_o & 15, (t_o >> 4) & 3); }
#pragma unroll 1
        for (int t = t_lo; t < t_hi; t += 2) {
            const bool last = (t == nt - 2);
            const char* a1 = cA + (size_t)(t + 1) * kstepA;
            const char* a2 = last ? nA : cA + (size_t)(t + 2) * kstepA; const char* b2 = last ? nB : cB + (size_t)(t + 2) * kstep;
            const char* a3 = a2 + kstepA; const char* b3 = b2 + kstep;
            if (last && has_next) S.a_ready(nxt);
            if constexpr (SP2) {
            PG8_LDB(B0, 0, 0); PG8_LDB(B1, 0, 1); PG8_SCHED; PG8_LDA(At, 0, 0); PG8_STAGEA(PG8_SA(1, 1), a1 + hstepA, voffA);
            PG8_WAIT_V(8); PG8_WAIT_L(0); PG8_BAR; PG8_MMA(0, 0, At, B0); PG8_MMA(0, 1, At, B1); PG8_BAR; PG8_SCHED;
            PG8_LDA(At, 0, 1); PG8_STAGE(PG8_SB(0, 0), b2, voffB); PG8_STAGE(PG8_SB(0, 1), b2 + hstep, voffB); PG8_STAGEA(PG8_SA(0, 0), a2, voffA);
            PG8_WAIT_V(8); PG8_WAIT_L(0); PG8_BAR; PG8_MMA(1, 0, At, B0); PG8_MMA(1, 1, At, B1); PG8_BAR; PG8_SCHED;
            PG8_LDB(B0, 1, 0); PG8_LDB(B1, 1, 1); PG8_SCHED; PG8_LDA(At, 1, 0); PG8_STAGEA(PG8_SA(0, 1), a2 + hstepA, voffA);
            PG8_WAIT_V(8); PG8_WAIT_L(0); PG8_BAR; PG8_MMA(0, 0, At, B0); PG8_MMA(0, 1, At, B1); PG8_BAR; PG8_SCHED;
            PG8_LDA(At, 1, 1); PG8_STAGE(PG8_SB(1, 0), b3, voffB); PG8_STAGE(PG8_SB(1, 1), b3 + hstep, voffB); PG8_STAGEA(PG8_SA(1, 0), a3, voffA);
            PG8_WAIT_V(8); PG8_WAIT_L(0); PG8_BAR; PG8_MMA(1, 0, At, B0); PG8_MMA(1, 1, At, B1); PG8_BAR; PG8_SCHED;
            } else {
            PG8_LDB(B0, 0, 0); PG8_SCHED; PG8_LDA(At, 0, 0); PG8_STAGEA(PG8_SA(1, 1), a1 + hstepA, voffA);
            PG8_WAIT_L(8); PG8_BAR; PG8_WAIT_L(0); PG8_MMA(0, 0, At, B0); PG8_BAR; PG8_SCHED;
            PG8_LDB(B1, 0, 1); PG8_STAGE(PG8_SB(0, 0), b2, voffB);
            PG8_BAR; PG8_WAIT_L(0); PG8_MMA(0, 1, At, B1); PG8_BAR;
            PG8_LDA(At, 0, 1); PG8_STAGEA(PG8_SA(0, 0), a2, voffA);
            PG8_BAR; PG8_WAIT_L(0); PG8_MMA(1, 0, At, B0); PG8_BAR; PG8_SCHED;
            PG8_STAGE(PG8_SB(0, 1), b2 + hstep, voffB);
            PG8_WAIT_V(6); PG8_BAR; PG8_MMA(1, 1, At, B1); PG8_BAR;
            PG8_LDB(B0, 1, 0); PG8_SCHED; PG8_LDA(At, 1, 0); PG8_STAGEA(PG8_SA(0, 1), a2 + hstepA, voffA);
            PG8_WAIT_L(8); PG8_BAR; PG8_WAIT_L(0); PG8_MMA(0, 0, At, B0); PG8_BAR; PG8_SCHED;
            PG8_LDB(B1, 1, 1); PG8_STAGE(PG8_SB(1, 0), b3, voffB);
            PG8_BAR; PG8_WAIT_L(0); PG8_MMA(0, 1, At, B1); PG8_BAR;
            PG8_LDA(At, 1, 1); PG8_STAGEA(PG8_SA(1, 0), a3, voffA);
            PG8_BAR; PG8_WAIT_L(0); PG8_MMA(1, 0, At, B0); PG8_BAR; PG8_SCHED;
            PG8_STAGE(PG8_SB(1, 1), b3 + hstep, voffB);
            PG8_WAIT_V(6); PG8_BAR; PG8_MMA(1, 1, At, B1); PG8_BAR;
            }
        }
        }
        if constexpr (ALIGN_EPI) { if (wr == 0) PG8_BAR; }
        if constexpr (!Epi::AFTER_DRAIN) { int t_o = threadIdx.x; asm volatile("" : "+v"(t_o)); E(acc, cur, wr, wc, t_o & 15, (t_o >> 4) & 3); S.done(cur); }
        if (!has_next) break;
#pragma unroll
        for (int a = 0; a < 2; ++a)
#pragma unroll
            for (int b = 0; b < 2; ++b)
#pragma unroll
                for (int m = 0; m < 4; ++m)
#pragma unroll
                    for (int n = 0; n < 2; ++n) acc[a][b][m][n] = (f32x4){0.f, 0.f, 0.f, 0.f};
        cur = nxt; cA = nA; cB = nB; ++ui;
        if constexpr (ALIGN_EPI) { if (wr == 1) PG8_BAR; }
    }
    PG8_WAIT_V(0);
    if constexpr (!ALIGN_EPI) { if (wr == 0) PG8_BAR; }
    PG8_BAR;
    if constexpr (Epi::AFTER_DRAIN) { E.fused(acc, cur, wr, wc, fr, fq, lds, wid, lane); S.done(cur); }
#undef PG8_SA
#undef PG8_SB
#undef PG8_STAGE
#undef PG8_STAGEA
#undef PG8_STAGEX
#undef PG8_LDA
#undef PG8_LDB
#undef PG8_MMA
#undef PG8_F8
#undef PG8_WAIT_V
#undef PG8_WAIT_L
#undef PG8_BAR
#undef PG8_SCHED
}
}

constexpr int NWAVES = 8;
constexpr int BATCH = 8, SEQ = 2048, DM = 2048, DFF = 8192, M = BATCH * SEQ;
constexpr int D_IN = 12880, NQKV = 5120  , NQKV_W = 7680  , N1I = 1280  , N1 = NQKV_W + N1I, NG = 4096, N1T = N1 + NG;
constexpr int KP = 1536;
constexpr float LOG2E = 1.4426950408889634f;
constexpr float QK_C = 0.088388347648318440f * LOG2E;
constexpr float NEGV = -1e30f;
constexpr int NPH = 11;
#ifndef STAGGER_TICKS
#define STAGGER_TICKS 500
#endif
constexpr float W8_SCALE = 64.f, WP8_SCALE = 32.f, O8_SCALE = 16.f;

constexpr size_t MiB = 1u << 20;
constexpr size_t WS_CTL = 0, CTL_ZERO_BYTES = 1 * MiB;
constexpr size_t WS_W1Q8 = 1 * MiB, WS_W1G8 = 16 * MiB, WS_W1I = 24 * MiB, WS_WP8 = 29 * MiB, WS_WO8 = 32 * MiB, WS_WU = 36 * MiB, WS_WD = 68 * MiB;
constexpr size_t WS_X8 = 100 * MiB;
constexpr size_t WS_XB = 132 * MiB;
constexpr size_t WS_BIG = 196 * MiB;
constexpr size_t WS_QKV = WS_BIG, WS_KAF = WS_BIG + 160 * MiB, WS_KBF = WS_BIG + 208 * MiB, WS_QI = WS_BIG + 240 * MiB, WS_KI = WS_BIG + 272 * MiB, WS_WI = WS_BIG + 274 * MiB, WS_MASK = WS_BIG + 275 * MiB;
constexpr size_t WS_MG8 = WS_BIG + 128 * MiB, WS_H = WS_BIG;
constexpr size_t WS_R_LO = WS_KAF, WS_R_HI = WS_QI, WS_SB_LO = WS_BIG + 279 * MiB, G_HALF_BYTES = (size_t)(M / 2) * DM * 2;
constexpr size_t WS_END = 512 * MiB;
static_assert(WS_W1Q8 + (size_t)NQKV_W * DM <= WS_W1G8 && WS_W1G8 + (size_t)NG * DM <= WS_W1I && WS_W1I + (size_t)N1I * DM * 2 <= WS_WP8 && WS_WP8 + (size_t)DM * KP <= WS_WO8 && WS_WO8 + (size_t)DM * DM <= WS_WU && WS_WU + (size_t)DFF * DM * 2 <= WS_WD && WS_WD + (size_t)DM * DFF * 2 <= WS_X8 && WS_X8 + (size_t)M * DM <= WS_XB, "weights map");
static_assert(WS_XB + (size_t)M * DM * 2 <= WS_BIG && WS_QKV + (size_t)M * NQKV * 2 <= WS_KAF && WS_KAF + (size_t)M * 1536 * 2 <= WS_KBF && WS_KBF + (size_t)M * 1024 * 2 <= WS_QI && WS_QI + (size_t)M * 1024 * 2 <= WS_KI && WS_KI + (size_t)M * 64 * 2 <= WS_WI && WS_WI + (size_t)M * 16 * 4 <= WS_MASK && WS_MASK + (size_t)M * 64 * 4 <= WS_END, "activation map");
static_assert(WS_MG8 + (size_t)M * DM <= WS_KAF && WS_H + (size_t)M * DFF * 2 <= WS_END && WS_R_LO + G_HALF_BYTES <= WS_KBF && WS_R_HI + G_HALF_BYTES <= WS_KI && WS_MASK + (size_t)M * 64 * 4 <= WS_SB_LO && WS_SB_LO + G_HALF_BYTES <= WS_END, "overlay map");
constexpr size_t DO_OAP = 0, DO_LSE = 48 * MiB, DO_OAB = 64 * MiB, DO_SB_HI = 88 * MiB  ;
constexpr int CW_BAR = 4096;
constexpr size_t CTL_SS1 = 256 * 1024, CTL_SS2 = 320 * 1024, CTL_RSTD0 = 384 * 1024, CTL_PCNT = 448 * 1024;

constexpr int RING_BYTES = 131072;
constexpr int LDSCTL_OFF = 151552, MISC_OFF = LDSCTL_OFF + 320;
constexpr int LDS_BYTES = 155648;

#define GAS __attribute__((address_space(1)))
#define LAS __attribute__((address_space(3)))
typedef unsigned short bf16;
typedef unsigned v4u __attribute__((ext_vector_type(4)));
typedef float f32x4 __attribute__((ext_vector_type(4)));
typedef float f32x16 __attribute__((ext_vector_type(16)));
typedef short bf16x8 __attribute__((ext_vector_type(8)));
typedef short s16x4 __attribute__((ext_vector_type(4)));
typedef GAS unsigned gu32;
#define LDS_WAIT() asm volatile("s_waitcnt lgkmcnt(0)" ::: "memory")
#define VM_WAIT() asm volatile("s_waitcnt vmcnt(0)" ::: "memory")
#define SBAR() __builtin_amdgcn_sched_barrier(0)
__device__ __forceinline__ unsigned f2bf(float f) { unsigned u = __builtin_bit_cast(unsigned, f); return (u + 0x7fffu + ((u >> 16) & 1u)) >> 16; }
__device__ __forceinline__ unsigned pk2(float lo, float hi) { return f2bf(lo) | (f2bf(hi) << 16); }
__device__ __forceinline__ unsigned cvtpk(float lo, float hi) { unsigned r; asm volatile("v_cvt_pk_bf16_f32 %0, %1, %2" : "=v"(r) : "v"(lo), "v"(hi)); return r; }
__device__ __forceinline__ int crow(int r, int hi) { return (r & 3) + 8 * (r >> 2) + 4 * hi; }
__device__ __forceinline__ float wave_sum(float v) {
#pragma unroll
    for (int o = 1; o < 64; o <<= 1) v += __shfl_xor(v, o);
    return v;
}
__device__ __forceinline__ int t5_bucket(int n) {
    if (n < 16) return n;
    const int l = 16 + (int)(logf((float)n / 16.0f) / 4.852030263919617f * 16.0f);
    return l < 31 ? l : 31;
}
#define XB_TMO      128
#define XB_XCNT(j)  (256  + 64 * (j))
#define XB_XSUB(j)  (1280 + 64 * (j))
#define XB_XGEN(j)  (2304 + 64 * (j))
#define XB_TOP      3328
#define XB_TOPGEN   3392
#define XCD_BAR_WORDS 3456
#define XB_SPIN_CAP (1u << 18)

__device__ __forceinline__ unsigned xb_ld(unsigned* p)              { return __hip_atomic_load(p, __ATOMIC_RELAXED, __HIP_MEMORY_SCOPE_AGENT); }
__device__ __forceinline__ unsigned xb_add(unsigned* p, unsigned v) { return __hip_atomic_fetch_add(p, v, __ATOMIC_RELAXED, __HIP_MEMORY_SCOPE_AGENT); }
__device__ __forceinline__ unsigned xb_xcc_id() { return (unsigned)__builtin_amdgcn_s_getreg((3 << 11) | 20) & 0xFu; }
#define XB_SPIN(cond, bar) do { unsigned _sp = 0; while (cond) { __builtin_amdgcn_s_sleep(1); \
    if ((++_sp & 255u) == 0u) { if (xb_ld(&(bar)[XB_TMO])) break; if (_sp > XB_SPIN_CAP) { atomicAdd(&(bar)[XB_TMO], 1u); break; } } } } while (0)

struct XcdBarrier {
    unsigned* bar; unsigned x; unsigned G;
    volatile LAS unsigned* st;
};

__device__ __forceinline__ XcdBarrier xcd_barrier_post(unsigned* bar, volatile LAS unsigned* st) {
    XcdBarrier b; b.bar = bar; b.x = xb_xcc_id(); b.st = st;
    if (threadIdx.x == 0) (void)xb_add(&bar[XB_XCNT(b.x)], 1u);
    return b;
}
__device__ __forceinline__ void xcd_barrier_complete(unsigned* bar, unsigned x, unsigned& nloc, unsigned& nx, unsigned xb_grid) {
    const unsigned G = xb_grid;
    unsigned sum, cnt, mine, sp = 0u;
    for (;;) {
        sum = 0u; cnt = 0u; mine = 0u;
#pragma unroll
        for (unsigned j = 0; j < 16; ++j) { const unsigned c = xb_ld(&bar[XB_XCNT(j)]); sum += c; cnt += (c > 0u) ? 1u : 0u; mine = (j == x) ? c : mine; }
        if (sum == G) break;
        __builtin_amdgcn_s_sleep(1);
        if ((++sp & 255u) == 0u) { if (xb_ld(&bar[XB_TMO])) break; if (sp > XB_SPIN_CAP) { atomicAdd(&bar[XB_TMO], 1u); break; } }
    }
    nloc = mine > 0u ? mine : 1u; nx = cnt > 0u ? cnt : 1u;
}

__device__ __forceinline__ void xcd_barrier(const XcdBarrier& b) {
    asm volatile("s_waitcnt vmcnt(0)" ::: "memory");
    __syncthreads();
    if (threadIdx.x == 0) {
        unsigned* bar = b.bar;
        __builtin_amdgcn_s_waitcnt(0);
        unsigned nloc = b.st[0], nx = b.st[1];
        if (nloc == 0u) { xcd_barrier_complete(bar, b.x, nloc, nx, b.G); b.st[0] = nloc; b.st[1] = nx; }
        const unsigned old = xb_add(&bar[XB_XSUB(b.x)], 1u);
        const unsigned gen = old / nloc;
        if (old + 1u == (gen + 1u) * nloc) {
            __builtin_amdgcn_fence(__ATOMIC_RELEASE, "agent");
            asm volatile("s_waitcnt vmcnt(0)" ::: "memory");
            const unsigned og = xb_add(&bar[XB_TOP], 1u);
            const unsigned tg = og / nx;
            if (og + 1u == (tg + 1u) * nx) xb_add(&bar[XB_TOPGEN], 1u);
            else XB_SPIN(xb_ld(&bar[XB_TOPGEN]) == tg, bar);
            __builtin_amdgcn_fence(__ATOMIC_ACQUIRE, "agent");
            xb_add(&bar[XB_XGEN(b.x)], 1u);
            asm volatile("s_waitcnt vmcnt(0)" ::: "memory");
        } else {
            XB_SPIN(xb_ld(&bar[XB_XGEN(b.x)]) == gen, bar);
            __builtin_amdgcn_fence(__ATOMIC_ACQUIRE, "agent");
            asm volatile("s_waitcnt vmcnt(0)" ::: "memory");
        }
    }
    __syncthreads();
}

struct Frame {
    LAS unsigned char* lds;
    volatile LAS unsigned* MISC;
    gu32* ctl;
    int tid, lane, wave, vcu, G;
};

__device__ __forceinline__ unsigned pk4_fp8(float a, float b, float c, float d) { int v = 0; v = __builtin_amdgcn_cvt_pk_fp8_f32(a, b, v, false); v = __builtin_amdgcn_cvt_pk_fp8_f32(c, d, v, true); return (unsigned)v; }
template <bool F8>
__device__ __forceinline__ void p0_transpose_item(const float* __restrict__ W, int ldw, const float* __restrict__ gk, float scale, void* __restrict__ WTv, int ldt, int koff, int k0, int n0, int srccol4, LAS float* scr, int lane) {
    const int nq = lane & 15, kr = lane >> 4;
    f32x4 v[16];
#pragma unroll
    for (int i = 0; i < 16; ++i) { v[i] = (f32x4){0.f, 0.f, 0.f, 0.f}; if (srccol4 >= 0) v[i] = __builtin_nontemporal_load((const GAS f32x4*)(W + (size_t)(k0 + 4 * i + kr) * ldw + srccol4)); }
#pragma unroll
    for (int i = 0; i < 16; ++i) v[i] = v[i] * (gk ? gk[k0 + 4 * i + kr] * scale : scale);
#pragma unroll
    for (int i = 0; i < 16; ++i) *(LAS f32x4*)(scr + (4 * i + kr) * 68 + 4 * nq) = v[i];
    LDS_WAIT(); asm volatile("" ::: "memory");
    if constexpr (!F8) { bf16* WT = (bf16*)WTv; const int c = lane & 7;
#pragma unroll
        for (int j = 0; j < 8; ++j) { const int n = (lane >> 3) + 8 * j; const LAS float* s = scr + (8 * c) * 68 + n;
            v4u o; o.x = pk2(s[0 * 68], s[1 * 68]); o.y = pk2(s[2 * 68], s[3 * 68]); o.z = pk2(s[4 * 68], s[5 * 68]); o.w = pk2(s[6 * 68], s[7 * 68]);
            __builtin_nontemporal_store(o, (GAS v4u*)(WT + (size_t)(n0 + n) * ldt + koff + k0 + 8 * c)); }
    } else { unsigned char* WT = (unsigned char*)WTv; const int c = lane & 3;
#pragma unroll
        for (int j = 0; j < 4; ++j) { const int n = (lane >> 2) + 16 * j; const LAS float* s = scr + (16 * c) * 68 + n;
            v4u o; o.x = pk4_fp8(s[0 * 68], s[1 * 68], s[2 * 68], s[3 * 68]); o.y = pk4_fp8(s[4 * 68], s[5 * 68], s[6 * 68], s[7 * 68]); o.z = pk4_fp8(s[8 * 68], s[9 * 68], s[10 * 68], s[11 * 68]); o.w = pk4_fp8(s[12 * 68], s[13 * 68], s[14 * 68], s[15 * 68]);
            __builtin_nontemporal_store(o, (GAS v4u*)(WT + (size_t)(n0 + n) * ldt + koff + k0 + 16 * c)); }
    }
    LDS_WAIT(); asm volatile("" ::: "memory");
}
__device__ __forceinline__ int w1_srccol(int n) {
    if (n < 8704) return n;
    if (n < N1) { const int c = n - 8704; if (c < 32) return 8704 + c; if (c < 48) return 8768 + (c - 32); if (c >= 128 && c < 160) return 8704 + 32 + (c - 128); return -1; }
    { const int c = n - N1; return 8784 + ((c >> 7) & 1) * 2048 + (c >> 8) * 128 + (c & 127); }
}
struct P0Args { const float *x, *g_mix, *w_in, *w_pa, *w_pb, *w_out, *g_mlp, *w_up, *w_dn; unsigned char *W1Q8, *W1G8; bf16* W1I; unsigned char *WP8, *WO8; bf16 *WUt, *WDt, *XB; unsigned char* X8; float* rstd0; };
template <bool DEFERRED>
__device__ __forceinline__ void p0_prologue(Frame& F, const P0Args& A) {
    LAS float* scr = (LAS float*)(F.lds + F.wave * 17408);
    const int gw = F.vcu * NWAVES + F.wave, NGW = F.G * NWAVES;
    constexpr int I_E = (DM / 64) * (N1 / 64), I_G = (DM / 64) * (NG / 64), I_PA = (512 / 64) * (DM / 64), I_PB = (1024 / 64) * (DM / 64), I_O = (DM / 64) * (DM / 64), I_U = (DM / 64) * (DFF / 64), I_D = (DFF / 64) * (DM / 64);
    constexpr int NITEMS = DEFERRED ? I_G + I_PA + I_PB + I_O + I_U + I_D : I_E;
    const int nq4 = 4 * (F.lane & 15);
    for (int it = gw; it < NITEMS; it += NGW) {
        int r = it;
        if constexpr (!DEFERRED) { const int nb = N1 / 64, kb = r / nb, n0 = 64 * (r % nb); const int sc4 = w1_srccol(n0 + nq4);
            if (n0 < NQKV_W) p0_transpose_item<true>(A.w_in, D_IN, A.g_mix, W8_SCALE, A.W1Q8, DM, 0, 64 * kb, n0, sc4, scr, F.lane);
            else p0_transpose_item<false>(A.w_in, D_IN, A.g_mix, 1.f, A.W1I, DM, 0, 64 * kb, n0 - NQKV_W, sc4, scr, F.lane);
        } else {
        if (r < I_G) { const int nb = NG / 64, kb = r / nb, n0 = 64 * (r % nb); p0_transpose_item<true>(A.w_in, D_IN, A.g_mix, W8_SCALE, A.W1G8, DM, 0, 64 * kb, n0, w1_srccol(N1 + n0 + nq4), scr, F.lane); continue; } r -= I_G;
        if (r < I_PA) { const int nb = DM / 64, kb = r / nb, n0 = 64 * (r % nb); p0_transpose_item<true>(A.w_pa, DM, nullptr, WP8_SCALE, A.WP8, KP, 0, 64 * kb, n0, n0 + nq4, scr, F.lane); continue; } r -= I_PA;
        if (r < I_PB) { const int nb = DM / 64, kb = r / nb, n0 = 64 * (r % nb); p0_transpose_item<true>(A.w_pb, DM, nullptr, WP8_SCALE, A.WP8, KP, 512, 64 * kb, n0, n0 + nq4, scr, F.lane); continue; } r -= I_PB;
        if (r < I_O) { const int nb = DM / 64, kb = r / nb, n0 = 64 * (r % nb); p0_transpose_item<true>(A.w_out, DM, nullptr, W8_SCALE, A.WO8, DM, 0, 64 * kb, n0, n0 + nq4, scr, F.lane); continue; } r -= I_O;
        if (r < I_U) { const int nb = DFF / 64, kb = r / nb, n0 = 64 * (r % nb); p0_transpose_item<false>(A.w_up, DFF, A.g_mlp, 1.f, A.WUt, DM, 0, 64 * kb, n0, n0 + nq4, scr, F.lane); continue; } r -= I_U;
        { const int nb = DM / 64, kb = r / nb, n0 = 64 * (r % nb); p0_transpose_item<false>(A.w_dn, DM, nullptr, 1.f, A.WDt, DFF, 0, 64 * kb, n0, n0 + nq4, scr, F.lane); }
        }
    }
    if constexpr (DEFERRED) return;
    for (int m = gw; m < M; m += NGW) {
        const GAS f32x4* xr = (const GAS f32x4*)(A.x + (size_t)m * DM) + F.lane; f32x4 v[8]; float s = 0.f;
#pragma unroll
        for (int j = 0; j < 8; ++j) { v[j] = __builtin_nontemporal_load(xr + 64 * j); s += (v[j].x * v[j].x + v[j].y * v[j].y) + (v[j].z * v[j].z + v[j].w * v[j].w); }
        s = wave_sum(s);
        GAS unsigned long long* o8 = (GAS unsigned long long*)(A.XB + (size_t)m * DM) + F.lane; GAS unsigned* o4 = (GAS unsigned*)(A.X8 + (size_t)m * DM) + F.lane;
#pragma unroll
        for (int j = 0; j < 8; ++j) { o8[64 * j] = (unsigned long long)pk2(v[j].x, v[j].y) | ((unsigned long long)pk2(v[j].z, v[j].w) << 32); o4[64 * j] = pk4_fp8(v[j].x, v[j].y, v[j].z, v[j].w); }
        if (F.lane == 0) A.rstd0[m] = 1.0f / sqrtf(s * (1.0f / DM) + 1e-6f);
    }
}

__device__ __forceinline__ int half32_sum_i(int v, int hi) {
    v += __builtin_amdgcn_update_dpp(0, v, 0xB1, 0xF, 0xF, true);
    v += __builtin_amdgcn_update_dpp(0, v, 0x4E, 0xF, 0xF, true);
    v += __builtin_amdgcn_update_dpp(0, v, 0x141, 0xF, 0xF, true);
    v += __builtin_amdgcn_update_dpp(0, v, 0x140, 0xF, 0xF, true);
    const int t0 = __builtin_amdgcn_readlane(v, 0) + __builtin_amdgcn_readlane(v, 16), t1 = __builtin_amdgcn_readlane(v, 32) + __builtin_amdgcn_readlane(v, 48);
    return hi ? t1 : t0;
}
__device__ __forceinline__ float relu_i(float x) { const int b = __float_as_int(x); return __int_as_float(b > 0 ? b : 0); }
__device__ __forceinline__ void index_unit(const bf16* __restrict__ QI, const bf16* __restrict__ KI, const float* __restrict__ WI, unsigned* __restrict__ MASK, int b, int t0, int lane) {
    const int rho = lane & 31, hi = lane >> 5;
    const size_t tb = (size_t)b * SEQ;
    bf16x8 a[4];
    { const bf16* ap = QI + (tb + t0 + ((rho >> 2) & 1)) * 1024 + ((rho & 3) + 4 * (rho >> 3)) * 64 + 8 * hi;
#pragma unroll
      for (int ks = 0; ks < 4; ++ks) a[ks] = *(const bf16x8*)(ap + 16 * ks); }
    float w[16];
    { const f32x4* wp = (const f32x4*)(WI + (tb + t0 + hi) * 16);
#pragma unroll
      for (int i = 0; i < 4; ++i) { const f32x4 v = wp[i]; w[4 * i] = v[0]; w[4 * i + 1] = v[1]; w[4 * i + 2] = v[2]; w[4 * i + 3] = v[3]; } }
    const int nkb = (t0 + 1) / 32 + 1;
    const bf16* kbase = KI + (tb >> 5) * 2048;
    unsigned kloff = (unsigned)lane * 8u; asm volatile("" : "+v"(kloff));
    const int tq = t0 + hi;
    float sc[64];
    bf16x8 bq[2][2][4];
    const int np = (nkb + 1) >> 1;
#define IDX_LOADP(slot, pp_) do { const bf16* kp_ = kbase + (size_t)(pp_) * 4096; _Pragma("unroll") for (int e = 0; e < 2; ++e) _Pragma("unroll") for (int ks = 0; ks < 4; ++ks) bq[slot][e][ks] = *(const bf16x8*)(kp_ + 2048 * e + 512 * ks + kloff); } while (0)
    IDX_LOADP(0, 0);
#pragma unroll
    for (int pp = 0; pp < 32; ++pp) {
        sc[2 * pp] = -FLT_MAX; sc[2 * pp + 1] = -FLT_MAX;
        if (pp < np) {
            if (pp + 1 < np) IDX_LOADP((pp + 1) & 1, pp + 1);
            f32x16 c0 = {}, c1 = {};
#pragma unroll
            for (int ks = 0; ks < 4; ++ks) { c0 = __builtin_amdgcn_mfma_f32_32x32x16_bf16(a[ks], bq[pp & 1][0][ks], c0, 0, 0, 0); c1 = __builtin_amdgcn_mfma_f32_32x32x16_bf16(a[ks], bq[pp & 1][1][ks], c1, 0, 0, 0); }
            float s0, s1;
            { typedef float f32x2 __attribute__((ext_vector_type(2)));
              f32x2 p0a = {0.f, 0.f}, p0b = {0.f, 0.f}, p1a = {0.f, 0.f}, p1b = {0.f, 0.f};
#define RELU_I(x) relu_i(x)
#pragma unroll
              for (int r = 0; r < 16; r += 4) { const f32x2 wa = {w[r], w[r + 1]}, wb = {w[r + 2], w[r + 3]};
                  p0a = __builtin_elementwise_fma((f32x2){RELU_I(c0[r]), RELU_I(c0[r + 1])}, wa, p0a); p0b = __builtin_elementwise_fma((f32x2){RELU_I(c0[r + 2]), RELU_I(c0[r + 3])}, wb, p0b);
                  p1a = __builtin_elementwise_fma((f32x2){RELU_I(c1[r]), RELU_I(c1[r + 1])}, wa, p1a); p1b = __builtin_elementwise_fma((f32x2){RELU_I(c1[r + 2]), RELU_I(c1[r + 3])}, wb, p1b); }
#undef RELU_I
              s0 = (p0a[0] + p0a[1]) + (p0b[0] + p0b[1]); s1 = (p1a[0] + p1a[1]) + (p1b[0] + p1b[1]); }
            if (pp + 1 < np) { sc[2 * pp] = s0; sc[2 * pp + 1] = s1; }
            else { sc[2 * pp] = (pp * 64 + rho <= tq) ? s0 : -FLT_MAX; sc[2 * pp + 1] = (pp * 64 + 32 + rho <= tq) ? s1 : -FLT_MAX; }
        }
    }
#undef IDX_LOADP
    float mx, mn;
    { float mxp[4] = {-FLT_MAX, -FLT_MAX, -FLT_MAX, -FLT_MAX}, mnp[4] = {FLT_MAX, FLT_MAX, FLT_MAX, FLT_MAX};
#pragma unroll
      for (int q = 0; q < 8; ++q) if (8 * q < nkb) {
#pragma unroll
          for (int kb = 8 * q; kb < 8 * q + 8; ++kb) { const float v = sc[kb]; mxp[kb & 3] = fmaxf(mxp[kb & 3], v); mnp[kb & 3] = (v > -FLT_MAX) ? fminf(mnp[kb & 3], v) : mnp[kb & 3]; } }
      mx = fmaxf(fmaxf(mxp[0], mxp[1]), fmaxf(mxp[2], mxp[3])); mn = fminf(fminf(mnp[0], mnp[1]), fminf(mnp[2], mnp[3])); }
#pragma unroll
    for (int o = 1; o < 32; o <<= 1) { mx = fmaxf(mx, __shfl_xor(mx, o)); mn = fminf(mn, __shfl_xor(mn, o)); }
    float lo = mn, hb = mx, thr = mn; bool done = (tq + 1 <= 256);
    if (done) thr = -3.0e38f;
    float flo = (float)(tq + 1) - 256.5f, fhb = 1.0f - 256.5f; int side = 0;
    for (int it = 0; it < 96; ++it) {
        if (__all(done)) break;
        float tfr = flo * __builtin_amdgcn_rcpf(flo - fhb);
        tfr = fminf(fmaxf(tfr, 0.02f), 0.98f);
        const float mid = lo + (hb - lo) * tfr;
        const bool stuck = !(mid > lo) || !(mid < hb);
        int cn = 0;
#pragma unroll
        for (int q = 0; q < 8; ++q) if (8 * q < nkb) {
#pragma unroll
            for (int kb = 8 * q; kb < 8 * q + 8; ++kb) cn += (sc[kb] >= mid) ? 1 : 0; }
        const int c = half32_sum_i(cn, hi);
        if (!done) {
            if (stuck) { thr = lo; done = true; }
            else if (c == 256) { thr = mid; done = true; }
            else if (c > 256) { lo = mid; flo = (float)c - 256.5f; if (side > 0) fhb *= 0.5f; side = 1; } else { hb = mid; fhb = (float)c - 256.5f; if (side < 0) flo *= 0.5f; side = -1; }
        }
    }
    if (!done) thr = lo;
    unsigned w0 = 0u, w1 = 0u;
    int lane_o = lane;
#pragma unroll
    for (int q = 0; q < 8; ++q) if (8 * q < nkb) {
#pragma unroll
      for (int kb = 8 * q; kb < 8 * q + 8; ++kb) { const unsigned long long bal = __ballot(sc[kb] >= thr); const unsigned blo = (unsigned)bal, bhi = (unsigned)(bal >> 32);
        w0 = (lane_o == kb) ? blo : w0; w1 = (lane_o == kb) ? bhi : w1;
        asm volatile("" : "+v"(w0), "+v"(w1), "+v"(lane_o)); } }
    MASK[(tb + t0) * 64 + lane] = w0; MASK[(tb + t0 + 1) * 64 + lane] = w1;
}

#define KSWZ(row, colB) ((row) * 256 + ((colB) ^ (((row) & 7) << 4)))
__device__ __forceinline__ int v_st(int k, int c) { const int kk = (k & ~0xC) | ((k & 4) << 1) | ((k & 8) >> 1); return ((kk >> 3) * 4 + (c >> 5)) * 512 + ((kk & 7) * 32 + (c & 31)) * 2; }
__device__ __forceinline__ int v_rd_base(int lane) { return ((lane & 3) << 3) | (((lane >> 2) & 3) << 6) | (((lane >> 4) & 1) << 5) | (((lane >> 5) & 1) << 8); }
constexpr int v_rd_off(int d0, int ks, int half) { return d0 * 512 + ks * 4096 + half * 2048; }
template <int OFF> __device__ __forceinline__ s16x4 tr_read(int vb) { s16x4 r; asm volatile("ds_read_b64_tr_b16 %0, %1 offset:%2" : "=&v"(r) : "v"(vb), "i"(OFF) : "memory"); return r; }
#define PKV(L, H) (bf16x8){L[0], L[1], L[2], L[3], H[0], H[1], H[2], H[3]}
#define PK4(P, BASE, OUT) do { unsigned a0_ = cvtpk(P[BASE + 0], P[BASE + 1]), a1_ = cvtpk(P[BASE + 2], P[BASE + 3]);   \
    unsigned b0_ = cvtpk(P[BASE + 4], P[BASE + 5]), b1_ = cvtpk(P[BASE + 6], P[BASE + 7]);                              \
    auto r0_ = __builtin_amdgcn_permlane32_swap(a0_, b0_, false, false); auto r1_ = __builtin_amdgcn_permlane32_swap(a1_, b1_, false, false); \
    v4u w_ = {r0_[0], r1_[0], r0_[1], r1_[1]}; OUT = __builtin_bit_cast(bf16x8, w_); } while (0)
__device__ __forceinline__ float half_max(float v) { auto rr = __builtin_amdgcn_permlane32_swap(__float_as_uint(v), __float_as_uint(v), false, false); return fmaxf(__uint_as_float(rr[0]), __uint_as_float(rr[1])); }
__device__ __forceinline__ float half_sum(float v) { auto rr = __builtin_amdgcn_permlane32_swap(__float_as_uint(v), __float_as_uint(v), false, false); return __uint_as_float(rr[0]) + __uint_as_float(rr[1]); }
__device__ __forceinline__ int lds_addr(const LAS void* p) { return (int)(unsigned)(uintptr_t)p; }

constexpr int WL_V = 0, WL_Q = 8192, WL_X = 16384, WL_BYTES = 16384 + 512;
constexpr int TABA_N = 192, TABB_N = 2112;
template <int MODE> struct WUnit {
    const bf16* qp; const bf16* kp; const bf16* vp;
    int dsh, r, p0; const LAS float* tab; const unsigned* mrow;
    LAS unsigned char* wl; int lane;
};
template <int MODE>
__device__ __forceinline__ void wu_block(const WUnit<MODE>& U, bf16x8 (&kc)[8], bf16x8 (&vs)[8], unsigned& mwr, bool has_next, int ps, int pn  , f32x16 (&o)[4], float& m_run, float& l_run) {
    const int q = U.lane & 31, hi = U.lane >> 5, vkey0 = U.lane >> 4, vcol = (U.lane & 15) * 8;
    const unsigned mw = mwr; (void)mw;
    static_assert(MODE == 0, "wu_block: the dilated-window path only (the bitmask path was replaced by the dense mixer-B body)");
    const int jb = U.p0 - ps + q - 4 * hi;
    const LAS float* tq_ = U.tab + (TABA_N - 1 - 32) - jb;
    const float mref = (m_run == NEGV) ? 0.f : m_run;
    f32x16 p, p2 = {};
#pragma unroll
    for (int rr = 0; rr < 16; ++rr) { const int cr = (rr & 3) + 8 * (rr >> 2); p[rr] = tq_[cr] - mref; }
#pragma unroll
    for (int d0 = 0; d0 < 8; d0 += 2) { p = __builtin_amdgcn_mfma_f32_32x32x16_bf16(kc[d0], *(const LAS bf16x8*)(U.wl + WL_Q + U.lane * 16 + d0 * 1024), p, 0, 0, 0);
        p2 = __builtin_amdgcn_mfma_f32_32x32x16_bf16(kc[d0 + 1], *(const LAS bf16x8*)(U.wl + WL_Q + U.lane * 16 + (d0 + 1) * 1024), p2, 0, 0, 0); }
    if (has_next) {
        const bf16* kp = U.kp + (size_t)(pn >> 5) * 4096 + U.lane * 8;
#pragma unroll
        for (int d0 = 0; d0 < 8; ++d0) kc[d0] = *(const bf16x8*)(kp + 512 * d0);
    }
    float pmax;
    { float pm4[4] = {NEGV, NEGV, NEGV, NEGV};
#pragma unroll
      for (int rr = 0; rr < 16; ++rr) { p[rr] += p2[rr]; pm4[rr & 3] = fmaxf(pm4[rr & 3], p[rr]); }
      pmax = fmaxf(fmaxf(pm4[0], pm4[1]), fmaxf(pm4[2], pm4[3])); }
    pmax = half_max(pmax);
    const bool started = (m_run != NEGV), live = pmax > 0.5f * NEGV;
    float alpha = 1.f;
    if (__builtin_expect(__any(started ? (pmax > 8.0f * LOG2E) : live), 0)) {
        const float delta = started ? fmaxf(pmax, 0.f) : (live ? pmax : 0.f);
        alpha = started ? __builtin_amdgcn_exp2f(-delta) : (live ? 0.f : 1.f);
        m_run = started ? m_run + delta : (live ? delta : NEGV);
#pragma unroll
        for (int rr = 0; rr < 16; ++rr) p[rr] -= delta; }
    float psum;
    { float ps4[4] = {0.f, 0.f, 0.f, 0.f};
#pragma unroll
      for (int rr = 0; rr < 16; ++rr) { p[rr] = __builtin_amdgcn_exp2f(p[rr]); ps4[rr & 3] += p[rr]; }
      psum = (ps4[0] + ps4[1]) + (ps4[2] + ps4[3]); }
    psum = half_sum(psum); l_run = l_run * alpha + psum;
    LAS float* al_l = (LAS float*)(U.wl + WL_X);
    if (__any(alpha < 1.f)) {
        if (hi == 0) al_l[q] = alpha;
        LDS_WAIT();
#pragma unroll
        for (int rr = 0; rr < 16; ++rr) { const float a = al_l[crow(rr, hi)];
#pragma unroll
            for (int d = 0; d < 4; ++d) o[d][rr] *= a; }
    }
    bf16x8 pa0, pa1; PK4(p, 0, pa0); PK4(p, 8, pa1);
#pragma unroll
    for (int i = 0; i < 8; ++i) *(LAS bf16x8*)(U.wl + WL_V + v_st(vkey0 + 4 * i, vcol)) = vs[i];
    if (has_next) {
        unsigned voff = (unsigned)(((vkey0 << U.dsh) + U.r) * NQKV + vcol); asm volatile("" : "+v"(voff));
        const bf16* vrow = U.vp + (size_t)(pn << U.dsh) * NQKV;
#pragma unroll
        for (int i = 0; i < 8; ++i) vs[i] = *(const bf16x8*)(vrow + (size_t)((4 * i) << U.dsh) * NQKV + voff);
    }
    asm volatile("" ::: "memory");
    const int vb = lds_addr(U.wl + WL_V) + v_rd_base(U.lane);
#define PVR(D0, l0, h0, l1, h1) const s16x4 l0 = tr_read<v_rd_off(D0, 0, 0)>(vb), h0 = tr_read<v_rd_off(D0, 0, 1)>(vb), l1 = tr_read<v_rd_off(D0, 1, 0)>(vb), h1 = tr_read<v_rd_off(D0, 1, 1)>(vb)
#define PVM(D0, l0, h0, l1, h1) do { o[D0] = __builtin_amdgcn_mfma_f32_32x32x16_bf16(pa0, PKV(l0, h0), o[D0], 0, 0, 0); o[D0] = __builtin_amdgcn_mfma_f32_32x32x16_bf16(pa1, PKV(l1, h1), o[D0], 0, 0, 0); } while (0)
    PVR(0, a0l, a0h, a1l, a1h); PVR(1, b0l, b0h, b1l, b1h);
    asm volatile("s_waitcnt lgkmcnt(0)" ::: "memory"); SBAR();
    PVR(2, c0l, c0h, c1l, c1h); PVR(3, d0l, d0h, d1l, d1h);
    PVM(0, a0l, a0h, a1l, a1h); PVM(1, b0l, b0h, b1l, b1h);
    asm volatile("s_waitcnt lgkmcnt(0)" ::: "memory"); SBAR();
    PVM(2, c0l, c0h, c1l, c1h); PVM(3, d0l, d0h, d1l, d1h);
#undef PVR
#undef PVM
}
template <int MODE>
__device__ __forceinline__ void wu_run(const WUnit<MODE>& U, int ps_begin, bool desc  , bf16* __restrict__ Ob, int ldo, float* __restrict__ lse) {
    const int q = U.lane & 31, hi = U.lane >> 5, vkey0 = U.lane >> 4, vcol = (U.lane & 15) * 8;
    { const bf16* qp = U.qp + (size_t)(((U.p0 + q) << U.dsh) + U.r) * NQKV + 8 * hi;
#pragma unroll
      for (int d0 = 0; d0 < 8; ++d0) *(LAS bf16x8*)(U.wl + WL_Q + U.lane * 16 + d0 * 1024) = *(const bf16x8*)(qp + 16 * d0); }
    f32x16 o[4] = {}; float m_run = NEGV, l_run = 0.f;
    bf16x8 kc[8], vs[8]; unsigned mw = 0u;
    { unsigned voff = (unsigned)(((vkey0 << U.dsh) + U.r) * NQKV + vcol); asm volatile("" : "+v"(voff));
      const bf16* vrow = U.vp + (size_t)((desc ? U.p0 : ps_begin) << U.dsh) * NQKV;
#pragma unroll
      for (int i = 0; i < 8; ++i) vs[i] = *(const bf16x8*)(vrow + (size_t)((4 * i) << U.dsh) * NQKV + voff); }
    const int ps0 = desc ? U.p0 : ps_begin, step = desc ? -32 : 32, nblk = ((U.p0 - ps_begin) >> 5) + 1;
    { const bf16* kp = U.kp + (size_t)(ps0 >> 5) * 4096 + U.lane * 8;
#pragma unroll
      for (int d0 = 0; d0 < 8; ++d0) kc[d0] = *(const bf16x8*)(kp + 512 * d0);
      if (MODE == 1) mw = U.mrow[ps0 >> 5]; }
#pragma unroll 1
    for (int k = 0, ps = ps0; k < nblk; ++k, ps += step) wu_block<MODE>(U, kc, vs, mw, k + 1 < nblk, ps, ps + step, o, m_run, l_run);
    LAS float* li_l = (LAS float*)(U.wl + WL_X) + 32;
    if (hi == 0) li_l[q] = l_run;
    LDS_WAIT();
    if (MODE == 0) {
#pragma unroll
        for (int rr = 0; rr < 16; ++rr) { const float rl = __builtin_amdgcn_rcpf(li_l[crow(rr, hi)]); LAS bf16* rowp = (LAS bf16*)(U.wl + WL_V + crow(rr, hi) * 256) + q;
#pragma unroll
            for (int d = 0; d < 4; ++d) rowp[32 * d] = (bf16)f2bf(o[d][rr] * rl); }
        LDS_WAIT();
        unsigned ooff = (unsigned)(((vkey0 << U.dsh) + U.r) * ldo + vcol); asm volatile("" : "+v"(ooff));
        bf16* orow = Ob + (size_t)(U.p0 << U.dsh) * ldo;
#pragma unroll
        for (int i = 0; i < 8; ++i) { const bf16x8 v = *(const LAS bf16x8*)(U.wl + WL_V + (vkey0 + 4 * i) * 256 + vcol * 2);
            *(bf16x8*)(orow + (size_t)((4 * i) << U.dsh) * ldo + ooff) = v; }
    } else {
#pragma unroll
        for (int rr = 0; rr < 16; ++rr) { const float rl = __builtin_amdgcn_rcpf(li_l[crow(rr, hi)]) * O8_SCALE; LAS unsigned char* rowp = U.wl + WL_V + crow(rr, hi) * 128 + q;
#pragma unroll
            for (int d = 0; d < 4; ++d) { const float x = o[d][rr] * rl; rowp[32 * d] = (unsigned char)__builtin_amdgcn_cvt_pk_fp8_f32(x, x, 0, false); } }
        LDS_WAIT();
        unsigned ooff = (unsigned)((U.lane >> 3) * ldo + (U.lane & 7) * 16); asm volatile("" : "+v"(ooff));
        unsigned char* orow = (unsigned char*)Ob + (size_t)U.p0 * ldo;
#pragma unroll
        for (int i = 0; i < 4; ++i) { const v4u v = *(const LAS v4u*)(U.wl + WL_V + ((U.lane >> 3) + 8 * i) * 128 + (U.lane & 7) * 16);
            *(v4u*)(orow + (size_t)(8 * i) * ldo + ooff) = v; }
    }
    if (MODE == 0) { if (hi == 0) lse[(size_t)(((U.p0 + q) << U.dsh) + U.r) * 4] = m_run + __builtin_amdgcn_logf(l_run); }
    LDS_WAIT();
}

namespace ab {
constexpr int D = 128, KVBLK = 64, LDQ = NQKV, LDK = NQKV, LDO = KP;
constexpr int SHM_V = KVBLK * D * 2, SHM_K = KVBLK * D * 2, SHM_ATTN = 2 * SHM_V + 2 * SHM_K + NWAVES * 64 * 4;
constexpr int GUARD = 260, TABD_N = GUARD + 2048, TABB_OFF = SHM_ATTN;
constexpr int QS_OFF = 77824, QS_WAVE = 8192;
constexpr float THR2 = 8.0f * LOG2E;
#ifndef AB_SDEPTH
#define AB_SDEPTH 1
#endif
constexpr int SDEPTH = AB_SDEPTH;
__device__ __forceinline__ void initSM(f32x16& p0, f32x16& p1, float m_reg, const LAS float* tp) {
    const float mref = (m_reg == NEGV) ? 0.f : m_reg;
#pragma unroll
    for (int r = 0; r < 16; ++r) { const int cr = (r & 3) + 8 * (r >> 2); p0[r] = tp[cr] - mref; }
    SBAR();
#pragma unroll
    for (int r = 0; r < 16; ++r) { const int cr = (r & 3) + 8 * (r >> 2); p1[r] = tp[32 + cr] - mref; }
}
__device__ __forceinline__ float msel(unsigned m, int bit, float x) {
    const unsigned k = (unsigned)__builtin_amdgcn_sbfe((int)m, (unsigned)bit, 1u); return __uint_as_float(__builtin_amdgcn_bitop3_b32(k, __float_as_uint(x), __float_as_uint(NEGV), 0xCA));
}
__device__ __forceinline__ void partialSM(f32x16& p0, f32x16& p1, float& m_reg, float& alpha, unsigned mlo, unsigned mhi) {
#pragma unroll
    for (int r = 0; r < 16; ++r) { const int cr = (r & 3) + 8 * (r >> 2); p0[r] = msel(mlo, cr, p0[r]); p1[r] = msel(mhi, cr, p1[r]); }
    float pmax;
    { float pm4[4] = {p0[0], p0[1], p0[2], p0[3]};
#pragma unroll
      for (int r = 4; r < 16; ++r) pm4[r & 3] = fmaxf(pm4[r & 3], p0[r]);
#pragma unroll
      for (int r = 0; r < 16; ++r) pm4[r & 3] = fmaxf(pm4[r & 3], p1[r]);
      pmax = fmaxf(fmaxf(pm4[0], pm4[1]), fmaxf(pm4[2], pm4[3])); }
    pmax = half_max(pmax);
    const bool started = (m_reg != NEGV), live = pmax > 0.5f * NEGV;
    if (__builtin_expect(!__any(started ? (pmax > THR2) : live), 1)) { alpha = 1.f; }
    else { const float delta = started ? fmaxf(pmax, 0.f) : (live ? pmax : 0.f);
        alpha = started ? __builtin_amdgcn_exp2f(-delta) : (live ? 0.f : 1.f);
        m_reg = started ? m_reg + delta : (live ? delta : NEGV);
#pragma unroll
        for (int r = 0; r < 16; ++r) { p0[r] -= delta; p1[r] -= delta; } }
#pragma unroll
    for (int r = 0; r < 16; ++r) p0[r] = __builtin_amdgcn_exp2f(p0[r]);
}
__device__ __forceinline__ void finishSM(f32x16& p0, f32x16& p1, float alpha, float& l_reg, bf16x8& pa0, bf16x8& pa1, bf16x8& pa2, bf16x8& pa3) {
#pragma unroll
    for (int r = 0; r < 16; ++r) p1[r] = __builtin_amdgcn_exp2f(p1[r]);
    float ps;
    { float ps4[4] = {0.f, 0.f, 0.f, 0.f};
#pragma unroll
      for (int r = 0; r < 16; ++r) ps4[r & 3] += p0[r];
#pragma unroll
      for (int r = 0; r < 16; ++r) ps4[r & 3] += p1[r];
      ps = (ps4[0] + ps4[1]) + (ps4[2] + ps4[3]); }
    ps = half_sum(ps);
    l_reg = l_reg * alpha + ps;
    PK4(p0, 0, pa0); PK4(p0, 8, pa1); PK4(p1, 0, pa2); PK4(p1, 8, pa3);
}
#ifndef AB_QREG
#define AB_QREG 1
#endif
__device__ __forceinline__ void qkt_r(f32x16& p0, f32x16& p1, const LAS unsigned char* Ks, const bf16x8 (&qf)[8], int r32, int hi) {
#pragma unroll
    for (int d0 = 0; d0 < 8; ++d0) { const int lo_ = (r32 + 32 * hi) * 16;
        const bf16x8 b0 = *(const LAS bf16x8*)(Ks + d0 * 1024 + lo_);
        const bf16x8 b1 = *(const LAS bf16x8*)(Ks + 8192 + d0 * 1024 + lo_);
        p0 = __builtin_amdgcn_mfma_f32_32x32x16_bf16(b0, qf[d0], p0, 0, 0, 0);
        p1 = __builtin_amdgcn_mfma_f32_32x32x16_bf16(b1, qf[d0], p1, 0, 0, 0); }
}
__device__ __forceinline__ void qkt(f32x16& p0, f32x16& p1, const LAS unsigned char* Ks, const LAS unsigned char* qs, int r32, int hi) {
#pragma unroll
    for (int d0 = 0; d0 < 8; ++d0) { const int lo_ = (r32 + 32 * hi) * 16;
        const bf16x8 b0 = *(const LAS bf16x8*)(Ks + d0 * 1024 + lo_);
        const bf16x8 b1 = *(const LAS bf16x8*)(Ks + 8192 + d0 * 1024 + lo_);
        const bf16x8 q = *(const LAS bf16x8*)(qs + d0 * 1024);
        p0 = __builtin_amdgcn_mfma_f32_32x32x16_bf16(b0, q, p0, 0, 0, 0);
        p1 = __builtin_amdgcn_mfma_f32_32x32x16_bf16(b1, q, p1, 0, 0, 0); }
}
template <int D0> __device__ __forceinline__ void pv_one(f32x16& od, int vb, bf16x8 pa0, bf16x8 pa1, bf16x8 pa2, bf16x8 pa3) {
    const s16x4 l0 = tr_read<v_rd_off(D0, 0, 0)>(vb), h0 = tr_read<v_rd_off(D0, 0, 1)>(vb), l1 = tr_read<v_rd_off(D0, 1, 0)>(vb), h1 = tr_read<v_rd_off(D0, 1, 1)>(vb);
    const s16x4 l2 = tr_read<v_rd_off(D0, 2, 0)>(vb), h2 = tr_read<v_rd_off(D0, 2, 1)>(vb), l3 = tr_read<v_rd_off(D0, 3, 0)>(vb), h3 = tr_read<v_rd_off(D0, 3, 1)>(vb);
    asm volatile("s_waitcnt lgkmcnt(0)" ::: "memory"); SBAR();
    od = __builtin_amdgcn_mfma_f32_32x32x16_bf16(pa0, PKV(l0, h0), od, 0, 0, 0);
    od = __builtin_amdgcn_mfma_f32_32x32x16_bf16(pa1, PKV(l1, h1), od, 0, 0, 0);
    od = __builtin_amdgcn_mfma_f32_32x32x16_bf16(pa2, PKV(l2, h2), od, 0, 0, 0);
    od = __builtin_amdgcn_mfma_f32_32x32x16_bf16(pa3, PKV(l3, h3), od, 0, 0, 0);
}
__device__ __forceinline__ void pv_d0(f32x16* o, int vb, bf16x8 pa0, bf16x8 pa1, bf16x8 pa2, bf16x8 pa3) {
    pv_one<0>(o[0], vb, pa0, pa1, pa2, pa3); pv_one<1>(o[1], vb, pa0, pa1, pa2, pa3); pv_one<2>(o[2], vb, pa0, pa1, pa2, pa3); pv_one<3>(o[3], vb, pa0, pa1, pa2, pa3);
}
__device__ __forceinline__ void attnB_block(const bf16* __restrict__ Qb, const bf16* __restrict__ Kh, const bf16* __restrict__ Vh, unsigned char* __restrict__ Ob,
                                            const unsigned* __restrict__ mrow0, int tq0, int NT, LAS unsigned char* lds) {
    const int tid = threadIdx.x, wid = tid >> 6, lane = tid & 63, r32 = lane & 31, hi = lane >> 5;
    LAS unsigned char* V_lds = lds; LAS unsigned char* K_lds = lds + 2 * SHM_V;
    LAS float* ws = (LAS float*)(lds + 2 * SHM_V + 2 * SHM_K) + wid * 64; LAS float* li_l = ws; LAS float* al_l = ws + 32;
    float m_reg = NEGV, l_reg = 0; f32x16 o[4] = {};
    bf16x8 qf[8];
    LAS unsigned char* qr = lds + QS_OFF + wid * QS_WAVE + lane * 16;
    { unsigned qoff = (unsigned)((wid * 32 + r32) * LDQ + hi * 8) * 2u; asm volatile("" : "+v"(qoff));
#pragma unroll
      for (int d0 = 0; d0 < 8; ++d0) { qf[d0] = *(const bf16x8*)((const char*)Qb + qoff + d0 * 32); if (!AB_QREG) *(LAS bf16x8*)(qr + d0 * 1024) = qf[d0]; } }
    const int sr = tid >> 4, sc = (tid & 15) * 8, vst0 = v_st(sr, sc), vst1 = vst0 + 8192;
    const int vb0 = lds_addr(V_lds) + v_rd_base(lane);
    unsigned voffV = (unsigned)(sr * LDK + sc) * 2u, voffK = (unsigned)tid * 16u, voffM = (unsigned)(wid * 32 + r32) * 256u; asm volatile("" : "+v"(voffV), "+v"(voffK), "+v"(voffM));
    const LAS float* tp0 = (const LAS float*)(lds + TABB_OFF) + (TABD_N - 1 - GUARD - (tq0 + wid * 32 + r32) + 4 * hi);
    struct { bf16x8 vs0, vs1, ks0, ks1; unsigned long long mk; } sr_[SDEPTH];
#define SLOAD(i, k0) do { const char* vb_ = (const char*)Vh + (size_t)(k0) * (LDK * 2); const char* kb_ = (const char*)Kh + (size_t)(k0) * 256; \
    sr_[i].vs0 = *(const bf16x8*)(vb_ + voffV); sr_[i].vs1 = *(const bf16x8*)(vb_ + 32 * LDK * 2 + voffV); \
    sr_[i].ks0 = *(const bf16x8*)(kb_ + voffK); sr_[i].ks1 = *(const bf16x8*)(kb_ + 8192 + voffK); sr_[i].mk = *(const unsigned long long*)((const char*)mrow0 + (size_t)((k0) >> 6) * 8 + voffM); } while (0)
#define SWRITE(b, i) do { *(LAS bf16x8*)(V_lds + (b) * SHM_V + vst0) = sr_[i].vs0; *(LAS bf16x8*)(V_lds + (b) * SHM_V + vst1) = sr_[i].vs1; const int kc = sc * 2;  \
    *(LAS bf16x8*)(K_lds + (b) * SHM_K + voffK) = sr_[i].ks0; *(LAS bf16x8*)(K_lds + (b) * SHM_K + 8192 + voffK) = sr_[i].ks1; (void)kc; } while (0)
#define SWAIT() do { if constexpr (SDEPTH == 2) asm volatile("s_waitcnt vmcnt(5)" ::: "memory"); else asm volatile("s_waitcnt vmcnt(0)" ::: "memory"); } while (0)
#define RESC(a) do { if (__any((a) < 1.f)) { if (hi == 0) al_l[r32] = (a); asm volatile("s_waitcnt lgkmcnt(0)" ::: "memory"); \
    _Pragma("unroll") for (int d = 0; d < 4; ++d) _Pragma("unroll") for (int r = 0; r < 16; ++r) o[d][r] *= al_l[crow(r, hi)]; } } while (0)
#define QKT(P0, P1, KS) do { if (AB_QREG) qkt_r(P0, P1, KS, qf, r32, hi); else qkt(P0, P1, KS, qr, r32, hi); } while (0)
#define MLO(m) ((unsigned)(m) >> (4 * hi))
#define MHI(m) ((unsigned)((m) >> 32) >> (4 * hi))
    f32x16 pA0, pA1, pB0, pB1; float alA, alB; bf16x8 pa0, pa1, pa2, pa3; unsigned long long mA, mB;
    constexpr int SE = 0, SO = SDEPTH - 1;
    if (__builtin_amdgcn_readfirstlane(threadIdx.x) >= 256) __builtin_amdgcn_s_setprio(1);
    SLOAD(SE, 0); asm volatile("s_waitcnt vmcnt(0)" ::: "memory"); SWRITE(0, SE); mA = sr_[SE].mk; __syncthreads();
    initSM(pA0, pA1, m_reg, tp0); QKT(pA0, pA1, K_lds); partialSM(pA0, pA1, m_reg, alA, MLO(mA), MHI(mA));
    SLOAD(SO, KVBLK); if constexpr (SDEPTH == 2) { if (2 < NT) SLOAD(SE, 2 * KVBLK); }
    SWAIT(); SWRITE(1, SO); mB = sr_[SO].mk; __syncthreads();
    for (int j = 1; j + 1 < NT; j += 2) {
        SBAR(); initSM(pB0, pB1, m_reg, tp0 + j * KVBLK); QKT(pB0, pB1, K_lds + SHM_K);
        finishSM(pA0, pA1, alA, l_reg, pa0, pa1, pa2, pa3); SBAR();
        SLOAD(SO, (j + SDEPTH) * KVBLK); SBAR();
        pv_d0(o, vb0, pa0, pa1, pa2, pa3); partialSM(pB0, pB1, m_reg, alB, MLO(mB), MHI(mB));
        __syncthreads(); SWAIT(); SWRITE(0, SE); mA = sr_[SE].mk;
        RESC(alB); __syncthreads();
        SBAR(); initSM(pA0, pA1, m_reg, tp0 + (j + 1) * KVBLK); QKT(pA0, pA1, K_lds);
        finishSM(pB0, pB1, alB, l_reg, pa0, pa1, pa2, pa3); SBAR();
        if (SDEPTH == 1 || j + 3 < NT) SLOAD(SE, (j + 1 + SDEPTH) * KVBLK); SBAR();
        pv_d0(o, vb0 + SHM_V, pa0, pa1, pa2, pa3); partialSM(pA0, pA1, m_reg, alA, MLO(mA), MHI(mA));
        __syncthreads(); SWAIT(); SWRITE(1, SO); mB = sr_[SO].mk;
        RESC(alA); __syncthreads();
    }
    SBAR(); initSM(pB0, pB1, m_reg, tp0 + (NT - 1) * KVBLK); QKT(pB0, pB1, K_lds + SHM_K);
    finishSM(pA0, pA1, alA, l_reg, pa0, pa1, pa2, pa3); SBAR();
    pv_d0(o, vb0, pa0, pa1, pa2, pa3); partialSM(pB0, pB1, m_reg, alB, MLO(mB), MHI(mB));
    __syncthreads(); RESC(alB);
    finishSM(pB0, pB1, alB, l_reg, pa0, pa1, pa2, pa3); SBAR();
    pv_d0(o, vb0 + SHM_V, pa0, pa1, pa2, pa3);
    __builtin_amdgcn_s_setprio(0);
    if (hi == 0) li_l[r32] = l_reg; asm volatile("s_waitcnt lgkmcnt(0)" ::: "memory");
    LAS unsigned char* st = lds + QS_OFF + wid * QS_WAVE;
    int le = lane; asm volatile("" : "+v"(le)); const int r32e = le & 31, hie = le >> 5;
#pragma unroll
    for (int r = 0; r < 16; ++r) { const float rl = __builtin_amdgcn_rcpf(li_l[crow(r, hie)]) * O8_SCALE; LAS unsigned char* rowp = st + crow(r, hie) * 128 + r32e;
#pragma unroll
        for (int d0 = 0; d0 < 4; ++d0) { const float x = o[d0][r] * rl; rowp[32 * d0] = (unsigned char)__builtin_amdgcn_cvt_pk_fp8_f32(x, x, 0, false); } }
    asm volatile("s_waitcnt lgkmcnt(0)" ::: "memory");
    unsigned char* Ow = Ob + (long)(wid * 32) * LDO;
#pragma unroll
    for (int i = 0; i < 4; ++i) { const int row = (le >> 3) + 8 * i; const v4u v = *(const LAS v4u*)(st + row * 128 + (le & 7) * 16); *(v4u*)(Ow + (long)row * LDO + (le & 7) * 16) = v; }
    asm volatile("s_waitcnt lgkmcnt(0)" ::: "memory");
#undef SLOAD
#undef SWRITE
#undef SWAIT
#undef RESC
#undef MLO
#undef QKT
#undef MHI
}
}
struct Args { const float* in[13]; float* out; unsigned char* ws; int ph_lo, ph_hi, grid, pad; };
__global__ void __launch_bounds__(NWAVES * 64, 2) fwd(Args args) {
    extern __shared__ __attribute__((aligned(16))) unsigned char lds_raw[];
    Frame F;
    F.lds = (LAS unsigned char*)lds_raw;
    F.MISC = (volatile LAS unsigned*)(F.lds + MISC_OFF);
    F.tid = threadIdx.x; F.lane = F.tid & 63; F.wave = __builtin_amdgcn_readfirstlane(F.tid >> 6);
#define KA(A_) const __attribute__((address_space(4))) Args* A_ = (const __attribute__((address_space(4))) Args*)__builtin_amdgcn_kernarg_segment_ptr(); asm volatile("" : "+s"(A_))
    int lo, hi;
#define FRAME() do { KA(Af_); F.ctl = (gu32*)(Af_->ws + WS_CTL); lo = Af_->ph_lo; hi = Af_->ph_hi; F.lds = (LAS unsigned char*)lds_raw; F.MISC = (volatile LAS unsigned*)(F.lds + MISC_OFF); \
        F.tid = threadIdx.x; asm volatile("" : "+v"(F.tid)); F.lane = F.tid & 63; F.wave = __builtin_amdgcn_readfirstlane(F.tid >> 6); F.G = Af_->grid; { const int bx = blockIdx.x; F.vcu = (F.G % 8 == 0) ? (bx % 8) * (F.G / 8) + bx / 8 : bx; } } while (0)
    FRAME();
    for (int u = F.tid; u < (LDS_BYTES - LDSCTL_OFF) / 4; u += NWAVES * 64) ((LAS unsigned*)(F.lds + LDSCTL_OFF))[u] = 0u;
    __syncthreads();
    if (hi - lo > 1) (void)xcd_barrier_post((unsigned*)(F.ctl + CW_BAR), F.MISC + 8);
#define SEAM(k) do { FRAME(); if (IN(k) && IN((k) + 1)) { XcdBarrier bar_; bar_.bar = (unsigned*)(F.ctl + CW_BAR); bar_.x = xb_xcc_id(); bar_.G = (unsigned)F.G; bar_.st = F.MISC + 8; xcd_barrier(bar_); } } while (0)
#ifdef PH_ONLY
#define IN(k) ((k) == PH_ONLY && lo <= (k) && (k) < hi)
#else
#define IN(k) (lo <= (k) && (k) < hi)
#endif

#define P0ARGS(A_, Ap_, ws_) P0Args A_{Ap_->in[0], Ap_->in[1], Ap_->in[2], Ap_->in[6], Ap_->in[7], Ap_->in[8], Ap_->in[9], Ap_->in[10], Ap_->in[11], ws_ + WS_W1Q8, ws_ + WS_W1G8, (bf16*)(ws_ + WS_W1I), ws_ + WS_WP8, ws_ + WS_WO8, \
        (bf16*)(ws_ + WS_WU), (bf16*)(ws_ + WS_WD), (bf16*)(ws_ + WS_XB), ws_ + WS_X8, (float*)(ws_ + CTL_RSTD0)}
#define P0_DEFERRED_SLOT(slot_) do { if (((((int)blockIdx.x & 7) * 3) >> 3) == (slot_)) { __syncthreads(); { KA(Ad_); unsigned char* wsd_ = Ad_->ws; P0ARGS(Ad, Ad_, wsd_); FRAME(); p0_prologue<true>(F, Ad); } __syncthreads(); } } while (0)
    FRAME();
    if (IN(0)) {
        KA(Ap); unsigned char* ws = Ap->ws;
        { P0ARGS(A, Ap, ws); p0_prologue<false>(F, A); }
        SEAM(0);
    }
    FRAME();
    if (IN(1)) {
        P0_DEFERRED_SLOT(0);
        KA(Ap); unsigned char* ws = Ap->ws;
        const bool bal = (F.G == 256);
        { pg8::Gemm g{(bf16*)(ws + WS_X8), (bf16*)(ws + WS_W1Q8), M, NQKV_W, DM / 2};
          pg8::BalancedOrder S; if (bal) S.init(M, NQKV_W, F.G, (int)blockIdx.x, 6, 192, 2, true); else S.init(M, NQKV_W, F.G, (int)blockIdx.x, 1 << 20, 0, 0, true);
          pg8::EpiQKV E{1.0f / W8_SCALE, (bf16*)(ws + WS_QKV), (bf16*)(ws + WS_KAF), (size_t)(WS_KBF - WS_KAF) / 2, (const float*)(ws + CTL_RSTD0)};
          pg8::gemm_phase<pg8::EpiQKV, pg8::BalancedOrder, true, true, true>(F.lds, g, S, E); }
        __syncthreads();
        P0_DEFERRED_SLOT(1);
        { pg8::Gemm g{(bf16*)(ws + WS_XB), (bf16*)(ws + WS_W1I), M, N1I, DM};
          pg8::BalancedOrder S; if (bal) S.init(M, N1I, F.G, (int)blockIdx.x, 1, 192, 1, false); else S.init(M, N1I, F.G, (int)blockIdx.x, 1 << 20, 0, 0, true);
          typedef pg8::EpiIdx<WS_QI, WS_KI, WS_WI, CTL_RSTD0> EpiIdxT; EpiIdxT E{ws, Ap->in[3], Ap->in[4]};
          pg8::gemm_phase<EpiIdxT, pg8::BalancedOrder, true, true, false>(F.lds, g, S, E); }
        P0_DEFERRED_SLOT(2);
        SEAM(1);
    }
    FRAME();
    if (IN(2)) { }
    FRAME();
    if (IN(3)) {
        KA(Ap); unsigned char* ws = Ap->ws; unsigned char* dob = (unsigned char*)Ap->out;
        const bf16* QKV = (const bf16*)(ws + WS_QKV); const bf16* KAF = (const bf16*)(ws + WS_KAF); const bf16* QI = (const bf16*)(ws + WS_QI); const bf16* KI = (const bf16*)(ws + WS_KI); const float* WI = (const float*)(ws + WS_WI); unsigned* MASK = (unsigned*)(ws + WS_MASK);
        bf16* OAP = (bf16*)(dob + DO_OAP); float* LSE = (float*)(dob + DO_LSE);
        const float* tbl = Ap->in[5];
        LAS float* tabA = (LAS float*)(F.lds + NWAVES * WL_BYTES);
        for (int i = F.tid; i < 12 * TABA_N; i += NWAVES * 64) { const int gh = i / TABA_N, j = i % TABA_N - 32, g = gh >> 2;
            tabA[gh * TABA_N + (TABA_N - 1 - i % TABA_N)] = (j >= 0 && j <= 128) ? tbl[t5_bucket(j << (2 * g)) * 20 + gh] * LOG2E : NEGV; }
        __syncthreads();
        const int gw = F.vcu * NWAVES + F.wave, NGW = F.G * NWAVES;
#pragma unroll 1
        for (int st = 0; st < 2; ++st) { const bool do_idx = (st == 0) != (F.wave >= 4);
        if (do_idx) {
        for (int i = gw, j = 0; i < BATCH * (SEQ / 2); i += NGW, ++j) { const int b = i / (SEQ / 2), pi = i % (SEQ / 2); const int pr = (j & 1) ? (SEQ / 2 - 1 - pi) : pi;
            index_unit(QI, KI, WI, MASK, b, 2 * pr, F.lane); }
        } else {
        for (int i = gw; i < BATCH * 3 * 4 * 64; i += NGW) { const int u = i & 63, h = (i >> 6) & 3, g = (i >> 8) % 3, b = (i >> 8) / 3;
            const int nblk = (SEQ >> (2 * g)) / 32;
            const size_t tb = (size_t)b * SEQ; const int col = g * 512 + h * 128, p0 = (u % nblk) * 32, r = u / nblk;
            WUnit<0> U{QKV + tb * NQKV + col, KAF + ((size_t)(((b * 3 + g) * 4 + h) * 64 + r * nblk)) * 4096, QKV + tb * NQKV + 1536 + col, 2 * g, r, p0, tabA + (g * 4 + h) * TABA_N, nullptr, F.lds + F.wave * WL_BYTES, F.lane};
            wu_run<0>(U, p0 >= 128 ? p0 - 128 : 0, false, OAP + ((size_t)g * M + tb) * 512 + h * 128, 512, LSE + ((size_t)g * M + tb) * 4 + h); }
        } }
        VM_WAIT(); __syncthreads();
        SEAM(3);
    }
    FRAME();
    if (IN(4)) {
        KA(Ap); unsigned char* ws = Ap->ws; unsigned char* dob = (unsigned char*)Ap->out;
        const bf16* QKV = (const bf16*)(ws + WS_QKV); const bf16* KBF = (const bf16*)(ws + WS_KBF); const unsigned* MASK = (const unsigned*)(ws + WS_MASK);
        const bf16* OAP = (const bf16*)(dob + DO_OAP); const float* LSE = (const float*)(dob + DO_LSE); unsigned char* OAB = dob + DO_OAB;
        for (int pc = (int)blockIdx.x * (NWAVES * 64) + F.tid; pc < M * 64; pc += F.G * NWAVES * 64) { const int tok = pc >> 6, hh = (pc >> 4) & 3, c = (pc & 15) * 8;
            const float l0 = LSE[(size_t)tok * 4 + hh], l1 = LSE[((size_t)M + tok) * 4 + hh], l2 = LSE[((size_t)2 * M + tok) * 4 + hh];
            const float mx = fmaxf(l0, fmaxf(l1, l2)); float w0 = __builtin_amdgcn_exp2f(l0 - mx), w1 = __builtin_amdgcn_exp2f(l1 - mx), w2 = __builtin_amdgcn_exp2f(l2 - mx);
            const float inv = 1.0f / (w0 + w1 + w2); w0 *= inv; w1 *= inv; w2 *= inv;
            const size_t off = (size_t)tok * 512 + hh * 128 + c;
            const v4u a = *(const v4u*)(OAP + off), bq = *(const v4u*)(OAP + (size_t)M * 512 + off), cq = *(const v4u*)(OAP + (size_t)2 * M * 512 + off);
            f32x4 a0, a1, b0, b1, c0, c1; pg8::unpack8(a, a0, a1); pg8::unpack8(bq, b0, b1); pg8::unpack8(cq, c0, c1);
            const f32x4 r0 = (a0 * w0 + b0 * w1 + c0 * w2) * O8_SCALE, r1 = (a1 * w0 + b1 * w1 + c1 * w2) * O8_SCALE; typedef unsigned u32x2 __attribute__((ext_vector_type(2)));
            *(u32x2*)(OAB + (size_t)tok * KP + hh * 128 + c) = (u32x2){pk4_fp8(r0[0], r0[1], r0[2], r0[3]), pk4_fp8(r1[0], r1[1], r1[2], r1[3])}; }
        const float* tbl = Ap->in[5];
        LAS float* tabB = (LAS float*)(F.lds + ab::TABB_OFF);
        for (int u = F.vcu; u < BATCH * 8 * 4; u += F.G) { const int b = u >> 5, h = (u >> 2) & 7, xq = u & 3;
            __syncthreads();
            int ti_ = F.tid; asm volatile("" : "+v"(ti_));
            for (int i = ti_; i < ab::TABD_N; i += NWAVES * 64) { const int dist = i - ab::GUARD; tabB[ab::TABD_N - 1 - i] = dist >= 0 ? tbl[t5_bucket(dist) * 20 + 12 + h] * LOG2E : 0.f; }
            __syncthreads();
            const size_t tb = (size_t)b * SEQ;
#pragma unroll 1
            for (int half = 0; half < 2; ++half) { const int qb = half ? xq : 7 - xq; const size_t row0 = tb + (size_t)qb * 256;
                ab::attnB_block(QKV + row0 * NQKV + 3072 + h * 128, KBF + (size_t)((b * 8 + h) * 64) * 4096, QKV + tb * NQKV + 4096 + h * 128, OAB + row0 * KP + 512 + h * 128,
                                MASK + row0 * 64, qb * 256, 4 * (qb + 1), F.lds);
                __syncthreads(); }
        }
        VM_WAIT(); __syncthreads();
    }
    FRAME();
    if (IN(5)) {
        KA(Ap); unsigned char* ws = Ap->ws; bf16* Rlo = (bf16*)(ws + WS_R_LO); bf16* SBlo = (bf16*)(ws + WS_SB_LO);
        const long r_hi = ((long)WS_R_HI - (long)WS_R_LO) / 2 - (long)(M / 2) * DM, sb_hi = ((long)((uintptr_t)Ap->out + DO_SB_HI) - (long)(uintptr_t)(ws + WS_SB_LO)) / 2 - (long)(M / 2) * DM;
        pg8::Gemm g{(bf16*)(ws + WS_X8), (bf16*)(ws + WS_W1G8), M, NG, DM / 2}; pg8::DenseOrder<16> S; S.init(0, M / 256, F.G, (int)blockIdx.x, 1);
        pg8::EpiGate E{Rlo, SBlo, r_hi, sb_hi, (const float*)(ws + CTL_RSTD0), 1.0f / W8_SCALE};
        pg8::gemm_phase<pg8::EpiGate, pg8::DenseOrder<16>, true, true, true>(F.lds, g, S, E);
        SEAM(5);
    }
    FRAME();
    if (IN(6)) {
        KA(Ap); unsigned char* ws = Ap->ws; bf16* Rlo = (bf16*)(ws + WS_R_LO); bf16* SBlo = (bf16*)(ws + WS_SB_LO);
        const long r_hi = ((long)WS_R_HI - (long)WS_R_LO) / 2 - (long)(M / 2) * DM, sb_hi = ((long)((uintptr_t)Ap->out + DO_SB_HI) - (long)(uintptr_t)(ws + WS_SB_LO)) / 2 - (long)(M / 2) * DM;
        pg8::Gemm g{(bf16*)((unsigned char*)Ap->out + DO_OAB), (bf16*)(ws + WS_WP8), M, DM, KP / 2}; pg8::DenseOrder<8> S; S.init(0, M / 256, F.G, (int)blockIdx.x, 0);
        pg8::EpiMerged<4> E{ws + WS_MG8, Rlo, SBlo, r_hi, sb_hi, O8_SCALE / (O8_SCALE * WP8_SCALE)};
        pg8::gemm_phase<pg8::EpiMerged<4>, pg8::DenseOrder<8>, true, true, true>(F.lds, g, S, E);
        SEAM(6);
    }
    FRAME();
    if (IN(7)) {
        KA(Ap); unsigned char* ws = Ap->ws;
        pg8::Gemm g{(bf16*)(ws + WS_MG8), (bf16*)(ws + WS_WO8), M, DM, DM / 2}; pg8::DenseOrder<8> S; S.init(0, M / 256, F.G, (int)blockIdx.x, 1);
        pg8::EpiResid E{(bf16*)(ws + WS_XB), (float*)(ws + CTL_SS1), 1.0f / (O8_SCALE * W8_SCALE)};
        pg8::gemm_phase<pg8::EpiResid, pg8::DenseOrder<8>, true, true, true>(F.lds, g, S, E);
        SEAM(7);
    }
    FRAME();
    if (IN(8)) {
        KA(Ap); unsigned char* ws = Ap->ws;
        pg8::Gemm g{(bf16*)(ws + WS_XB), (bf16*)(ws + WS_WU), M, DFF, DM}; pg8::WeightStationaryOrder S; S.init(F.G, (int)blockIdx.x, 1);
        pg8::EpiUp E{(bf16*)(ws + WS_H), (const float*)(ws + CTL_SS1)};
        pg8::gemm_phase<pg8::EpiUp, pg8::WeightStationaryOrder, true, true>(F.lds, g, S, E);
        SEAM(8);
    }
    FRAME();
    if (IN(9)) {
        KA(Ap); unsigned char* ws = Ap->ws;
        pg8::Gemm g{(bf16*)(ws + WS_H), (bf16*)(ws + WS_WD), M, DM, DFF}; pg8::DenseOrder<8> S; S.init(0, M / 256, F.G, (int)blockIdx.x, 0);
        pg8::EpiResid E{(bf16*)(ws + WS_XB), (float*)(ws + CTL_SS2), 1.0f};
        pg8::gemm_phase<pg8::EpiResid, pg8::DenseOrder<8>, true, true, false, true>(F.lds, g, S, E);
        SEAM(9);
    }
    FRAME();
    if (IN(10)) {
        KA(Ap); const float* gf = Ap->in[12]; float* outp = Ap->out; const float* ss2 = (const float*)(Ap->ws + CTL_SS2); const bf16* x2b = (const bf16*)(Ap->ws + WS_XB);
        const int gw = F.vcu * NWAVES + F.wave, NGW = F.G * NWAVES;
        f32x4 gv[8];
#pragma unroll
        for (int q = 0; q < 4; ++q) { gv[2 * q] = *((const f32x4*)(gf + 512 * q + 8 * F.lane)); gv[2 * q + 1] = *((const f32x4*)(gf + 512 * q + 8 * F.lane + 4)); }
        for (int m = gw; m < M; m += NGW) { const float rs = 1.0f / sqrtf(ss2[m] * (1.0f / DM) + 1e-6f);
            const GAS v4u* xr = (const GAS v4u*)(x2b + (size_t)m * DM) + F.lane; GAS f32x4* orow = (GAS f32x4*)(outp + (size_t)m * DM) + 2 * F.lane;
            v4u w[4];
#pragma unroll
            for (int q = 0; q < 4; ++q) w[q] = xr[64 * q];
#pragma unroll
            for (int q = 0; q < 4; ++q) { f32x4 a, b; pg8::unpack8(w[q], a, b); orow[128 * q] = a * rs * gv[2 * q]; orow[128 * q + 1] = b * rs * gv[2 * q + 1]; } }
    }
#undef IN
#undef SEAM
}

#ifndef MK_N_LAUNCHES
#define MK_N_LAUNCHES 1
#endif
extern "C" void kernel_launch(void* const* d_in, const int* in_sizes, int n_in, void* d_out, int out_size, void* d_ws, size_t ws_size, hipStream_t stream) {
    static int grid = 0;
    if (grid == 0) {
        if (n_in != 13 || in_sizes[0] != M * DM || out_size != M * DM || ws_size < WS_END) { fprintf(stderr, "kernel_launch: shape/workspace mismatch (n_in %d, in0 %d, out %d, ws %zu; need ws >= %zu); nothing launched\n", n_in, n_in > 0 ? in_sizes[0] : -1, out_size, ws_size, (size_t)WS_END); grid = -1; return; }
        int dev = 0, cus = 0, per_cu = 0;
        if (hipGetDevice(&dev) != hipSuccess || hipDeviceGetAttribute(&cus, hipDeviceAttributeMultiprocessorCount, dev) != hipSuccess) { fprintf(stderr, "kernel_launch: device query failed\n"); grid = -1; return; }
        if (hipFuncSetAttribute((const void*)fwd, hipFuncAttributeMaxDynamicSharedMemorySize, LDS_BYTES) != hipSuccess) { fprintf(stderr, "kernel_launch: hipFuncSetAttribute(%d B LDS) failed\n", LDS_BYTES); grid = -1; return; }
        if (hipOccupancyMaxActiveBlocksPerMultiprocessor(&per_cu, (const void*)fwd, NWAVES * 64, LDS_BYTES) != hipSuccess || per_cu < 1) { fprintf(stderr, "kernel_launch: occupancy query reports %d workgroups per CU\n", per_cu); }
        (void)hipGetLastError();
        grid = cus;
    }
    if (grid < 0) return;
    if (hipMemsetAsync((char*)d_ws + WS_CTL, 0, CTL_ZERO_BYTES, stream) != hipSuccess) { fprintf(stderr, "kernel_launch: memset failed\n"); return; }
    Args a{};
    for (int i = 0; i < 13; ++i) a.in[i] = (const float*)d_in[i];
    a.out = (float*)d_out; a.ws = (unsigned char*)d_ws; a.grid = grid; a.pad = 0;
#if MK_N_LAUNCHES == 1
    a.ph_lo = 0; a.ph_hi = NPH;
    hipLaunchKernelGGL(fwd, dim3(grid), dim3(NWAVES * 64), LDS_BYTES, stream, a);
#else
    for (int p = 0; p < NPH; ++p) { a.ph_lo = p; a.ph_hi = p + 1; hipLaunchKernelGGL(fwd, dim3(grid), dim3(NWAVES * 64), LDS_BYTES, stream, a); }
#endif
    const hipError_t le = hipPeekAtLastError();
    if (le != hipSuccess) fprintf(stderr, "kernel_launch: launch failed: %s\n", hipGetErrorName(le));
}
```

```cpp
#include <hip/hip_runtime.h>
#include <cstdio>
#include <cstdint>
#include <cfloat>
namespace pg8 {
#define PG8_LAS __attribute__((address_space(3)))
typedef unsigned short bf16_t;
typedef short bf16x8 __attribute__((ext_vector_type(8)));
typedef float f32x4 __attribute__((ext_vector_type(4)));
typedef unsigned u32x4 __attribute__((ext_vector_type(4)));
typedef int i32x8 __attribute__((ext_vector_type(8)));
typedef int i32x4 __attribute__((ext_vector_type(4)));
__device__ __forceinline__ i32x8 f8cat(bf16x8 lo, bf16x8 hi) { const i32x4 a = __builtin_bit_cast(i32x4, lo), b = __builtin_bit_cast(i32x4, hi); return __builtin_shufflevector(a, b, 0, 1, 2, 3, 4, 5, 6, 7); }
constexpr int BM = 256, BK = 64, HALF = 128, HTB = HALF * BK * 2  , STAGE_BYTES = 8 * HTB, NXCD = 8, WGM = 8;

__host__ __device__ __forceinline__ int lds_byte(int r, int c) { const int st = (r >> 4) * 2 + (c >> 5), rr = r & 15, cc = c & 31, ob = rr * 64 + cc * 2; return st * 1024 + (ob ^ (((ob >> 9) & 1) << 5)); }
__host__ __device__ __forceinline__ void stage_rc(int b, int& R, int& C) { const int st = b / 1024, sb = b % 1024, swz = sb ^ (((sb >> 9) & 1) << 5); R = (st >> 1) * 16 + swz / 64; C = (st & 1) * 32 + (swz % 64) / 2; }
__host__ __device__ __forceinline__ int perm32(int rho) { const int n = rho >> 4, i = rho & 15; return 8 * (i >> 2) + 4 * n + (i & 3); }

struct Unit { int pm, pn, ui; };
struct Gemm { const bf16_t* A; const bf16_t* Bt; int M, N, K; };

struct StaticOrder {
    int nM, nN, nwg, G, c;
    __host__ __device__ void init(int M, int N, int G_, int c_) { nM = M / BM; nN = N / BM; nwg = nM * nN; G = G_; c = c_; }
    __host__ __device__ bool next(int i, Unit& u) const {
        const long L = (long)i * G + c; if (L >= nwg) return false;
        int wgid = (int)L; { const int q = nwg / NXCD, r = nwg % NXCD, xcd = wgid % NXCD, off = wgid / NXCD; wgid = (xcd < r ? xcd * (q + 1) : r * (q + 1) + (xcd - r) * q) + off; }
        const int nig = WGM * nN, gid = wgid / nig, fm = gid * WGM, gsz = (nM - fm) < WGM ? (nM - fm) : WGM;
        u.pm = fm + ((wgid % nig) % gsz); u.pn = (wgid % nig) / gsz; return true;
    }
    __device__ __forceinline__ void a_ready(const Unit&) const {}
    __device__ __forceinline__ void done(const Unit&) const {}
};
template <int NN>
struct DenseOrder {
    static constexpr int TG = NN / 8, PG = 8 / TG, PPR = 4 * PG;
    int pm_lo, npm, G, c, desc;
    __host__ __device__ void init(int pm_lo_, int npm_, int G_, int c_, int desc_) { pm_lo = pm_lo_; npm = npm_; G = G_; c = c_; desc = desc_; }
    __host__ __device__ bool next(int i, Unit& u) const {
        if (G != 256 || npm % PPR) { const long L = (long)i * G + c; if (L >= (long)npm * NN) return false; u.pm = pm_lo + (int)(L / NN); u.pn = (int)(L % NN); return true; }
        if (i * PPR >= npm) return false;
        const int x = c & 7, s = c >> 3, r = desc ? npm / PPR - 1 - i : i;
        u.pm = pm_lo + r * PPR + (x % PG) * 4 + (s >> 3); u.pn = (x / PG) * 8 + (s & 7); return true;
    }
    __device__ __forceinline__ void a_ready(const Unit&) const {}
    __device__ __forceinline__ void done(const Unit&) const {}
};
struct QkvOrder {
    int G, c;
    __host__ __device__ void init(int G_, int c_) { G = G_; c = c_; }
    __host__ __device__ bool next(int i, Unit& u) const {
        if (G != 256) { const long L = (long)i * G + c; if (L >= 64L * 30) return false; u.pm = (int)(L / 30); u.pn = (int)(L % 30); return true; }
        const int x = c & 7, s = c >> 3; if (s >= 30 || i >= 8) return false;
        u.pm = 8 * i + 2 * (x & 3) + s / 15; u.pn = 15 * (x >> 2) + s % 15; return true;
    }
    __device__ __forceinline__ void a_ready(const Unit&) const {}
    __device__ __forceinline__ void done(const Unit&) const {}
};
struct IdxOrder {
    int G, c;
    __host__ __device__ void init(int G_, int c_) { G = G_; c = c_; }
    __host__ __device__ bool next(int i, Unit& u) const {
        if (G != 256) { const long L = (long)i * G + c; if (L >= 64L * 5) return false; u.pm = (int)(L / 5); u.pn = (int)(L % 5); return true; }
        const int x = c & 7, s = c >> 3; int q;
        if (s >= 30) { if (i >= 5) return false; q = i * 16 + x * 2 + (s - 30); } else { if (i >= 1) return false; q = 80 + x * 30 + s; }
        u.pm = q / 5; u.pn = q % 5; return true;
    }
    __device__ __forceinline__ void a_ready(const Unit&) const {}
    __device__ __forceinline__ void done(const Unit&) const {}
};
struct WeightStationaryOrder {
    int G, c, desc;
    __host__ __device__ void init(int G_, int c_, int desc_) { G = G_; c = c_; desc = desc_; }
    __host__ __device__ bool next(int i, Unit& u) const {
        if (G != 256) { const long L = (long)i * G + c; if (L >= 64L * 32) return false; u.pm = (int)(L / 32); u.pn = (int)(L % 32); return true; }
        if (i >= 8) return false;
        const int x = c & 7, s = c >> 3, r = desc ? 7 - i : i; u.pm = r * 8 + (s >> 2); u.pn = x * 4 + (s & 3); return true;
    }
    __device__ __forceinline__ void a_ready(const Unit&) const {}
    __device__ __forceinline__ void done(const Unit&) const {}
};
struct RowPanelOrder {
    int nM, nN, G, v;
    __host__ __device__ void init(int M, int N, int G_, int v_) { nM = M / BM; nN = N / BM; G = G_; v = v_; }
    __host__ __device__ bool next(int i, Unit& u) const {
        if (G != 4 * nM || (nN & 3)) { const long L = (long)i * G + v; if (L >= (long)nM * nN) return false; u.pm = (int)(L / nN); u.pn = (int)(L % nN); return true; }
        const int per = nN >> 2; if (i >= per) return false; u.pm = v >> 2; u.pn = (v & 3) * per + i; return true;
    }
    __device__ __forceinline__ void a_ready(const Unit&) const {}
    __device__ __forceinline__ void done(const Unit&) const {}
};
struct BalancedOrder {
    StaticOrder base; int full, split, tail_per; bool low;
    __host__ __device__ void init(int M, int N, int G_, int c_, int full_, int split_, int tail_per_, bool low_) { base.init(M, N, G_, c_); full = full_; split = split_; tail_per = tail_per_; low = low_; }
    __host__ __device__ bool next(int i, Unit& u) const {
        if (i < full) return base.next(i, u);
        const int j = i - full; if (j >= tail_per) return false;
        const int c = base.c, G = base.G; int idx;
        if (low) { if (c >= split) return false; idx = j * split + c; } else { if (c < split) return false; idx = j * (G - split) + (c - split); }
        StaticOrder t = base; t.c = 0; t.G = 1;
        return t.next(full * G + idx, u);
    }
    __device__ __forceinline__ void a_ready(const Unit&) const {}
    __device__ __forceinline__ void done(const Unit&) const {}
};

__device__ __forceinline__ unsigned cvt_pk_bf16(float lo, float hi) { unsigned r; asm volatile("v_cvt_pk_bf16_f32 %0, %1, %2" : "=v"(r) : "v"(lo), "v"(hi)); return r; }
__device__ __forceinline__ u32x4 pack8(const f32x4 a, const f32x4 b) { u32x4 w; w.x = cvt_pk_bf16(a[0], a[1]); w.y = cvt_pk_bf16(a[2], a[3]); w.z = cvt_pk_bf16(b[0], b[1]); w.w = cvt_pk_bf16(b[2], b[3]); return w; }
__device__ __forceinline__ void unpack8(const u32x4 w, f32x4& a, f32x4& b) {
    a[0] = __uint_as_float(w.x << 16); a[1] = __uint_as_float(w.x & 0xffff0000u); a[2] = __uint_as_float(w.y << 16); a[3] = __uint_as_float(w.y & 0xffff0000u);
    b[0] = __uint_as_float(w.z << 16); b[1] = __uint_as_float(w.z & 0xffff0000u); b[2] = __uint_as_float(w.w << 16); b[3] = __uint_as_float(w.w & 0xffff0000u); }
__device__ __forceinline__ unsigned pk4_fp8(float a, float b, float c, float d) { int v = 0; v = __builtin_amdgcn_cvt_pk_fp8_f32(a, b, v, false); v = __builtin_amdgcn_cvt_pk_fp8_f32(c, d, v, true); return (unsigned)v; }
__device__ __forceinline__ float sigmoidf_(float x) { return __builtin_amdgcn_rcpf(1.0f + __builtin_amdgcn_exp2f(-1.4426950408889634f * x)); }

__device__ __forceinline__ void row_scalars(const float* p, int row0, float (&rs)[2][4]) {
#pragma unroll
    for (int ai = 0; ai < 2; ++ai)
#pragma unroll
        for (int m = 0; m < 4; ++m) rs[ai][m] = p[row0 + ai * HALF + m * 16];
    asm volatile("" : "+v"(rs[0][0]), "+v"(rs[0][1]), "+v"(rs[0][2]), "+v"(rs[0][3]), "+v"(rs[1][0]), "+v"(rs[1][1]), "+v"(rs[1][2]), "+v"(rs[1][3]) :: "memory");
}
constexpr float QKB_PRESCALE = 0.088388347648318440f * 1.4426950408889634f;
struct EpiQKV {
    static constexpr bool PERM = true, AFTER_DRAIN = false; static constexpr int HOOK_T = -1;
    float asc  ; bf16_t* QV; bf16_t* KAF; size_t kbf_delta  ; const float* rstd0;
    __device__ __forceinline__ void hook(f32x4 (&)[2][2][4][2], const Unit&, int, int, int, int) const {}
    __device__ __forceinline__ void operator()(const f32x4 (&acc)[2][2][4][2], const Unit& u, int wr, int wc, int fr, int fq) const {
        const int row0 = u.pm * BM + wr * 64 + fr, pn = u.pn;
        float rsv[2][4]; row_scalars(rstd0, row0, rsv);
        const bool is_ka = (pn >= 6 && pn < 12), is_kb = (pn >= 22 && pn < 26);
        if (is_ka || is_kb) {
            const int d0 = 2 * wc + (fq >> 1), hi = fq & 1;
#pragma unroll
            for (int ai = 0; ai < 2; ++ai)
#pragma unroll
                for (int m = 0; m < 4; ++m) { const int row = row0 + ai * HALF + m * 16; const float rs = rsv[ai][m] * asc; const int b = row >> 11, t = row & 2047;
#pragma unroll
                    for (int bj = 0; bj < 2; ++bj) { size_t off;
                        if (is_kb) { const int head = 2 * pn + bj - 44; off = ((size_t)(((b * 8 + head) * 64 + (t >> 5)) * 8 + d0)) * 512 + ((t & 31) + 32 * hi) * 8; }
                        else { const int gh = 2 * pn + bj - 12, g = gh >> 2, dsh = 2 * g, r = t & ((1 << dsh) - 1), p = t >> dsh;
                               off = ((size_t)((((b * 3 + g) * 4 + (gh & 3)) * 64 + r * (64 >> dsh) + (p >> 5)) * 8 + d0)) * 512 + ((p & 31) + 32 * hi) * 8; }
                        if (is_kb) off += kbf_delta;
                        *(u32x4*)(KAF + off) = pack8(acc[ai][bj][m][0] * rs, acc[ai][bj][m][1] * rs); } }
        } else {
            const int col0 = (pn < 6 ? pn : pn < 22 ? pn - 6 : pn - 10) * BM + wc * 32 + 8 * fq;
            const float qsc = (pn < 6 || (pn >= 18 && pn < 22)) ? QKB_PRESCALE : 1.0f;
#pragma unroll
            for (int ai = 0; ai < 2; ++ai)
#pragma unroll
                for (int m = 0; m < 4; ++m) { const int row = row0 + ai * HALF + m * 16; const float rs = rsv[ai][m] * asc * qsc; bf16_t* rowp = QV + (size_t)row * 5120 + col0;
#pragma unroll
                    for (int bj = 0; bj < 2; ++bj) *(u32x4*)(rowp + bj * HALF) = pack8(acc[ai][bj][m][0] * rs, acc[ai][bj][m][1] * rs); }
        }
    }
};
template <size_t O_QI, size_t O_KI, size_t O_WI, size_t O_RSTD> struct EpiIdx {
    static constexpr bool PERM = true, AFTER_DRAIN = false; static constexpr int HOOK_T = -1;
    unsigned char* ws; const float* lng; const float* lnb;
    __device__ __forceinline__ void hook(f32x4 (&)[2][2][4][2], const Unit&, int, int, int, int) const {}
    __device__ __forceinline__ void operator()(const f32x4 (&acc)[2][2][4][2], const Unit& u, int wr, int wc, int fr, int fq) const {
        bf16_t* QI = (bf16_t*)(ws + O_QI); bf16_t* KI = (bf16_t*)(ws + O_KI); float* WI = (float*)(ws + O_WI); const float* rstd0 = (const float*)(ws + O_RSTD);
        const int row0 = u.pm * BM + wr * 64 + fr, pn = u.pn + 30; const float asc = 1.0f;
        float rsv[2][4]; row_scalars(rstd0, row0, rsv);
        if (pn < 34) {
            bf16_t* base = QI; const int ldc = 1024, colt = (pn - 30) * BM; const float sc = 0.125f;
            const int col0 = colt + wc * 32 + 8 * fq;
#pragma unroll
            for (int ai = 0; ai < 2; ++ai)
#pragma unroll
                for (int m = 0; m < 4; ++m) { const int row = row0 + ai * HALF + m * 16; const float rs = rsv[ai][m] * sc; bf16_t* rowp = base + (size_t)row * ldc + col0;
#pragma unroll
                    for (int bj = 0; bj < 2; ++bj) *(u32x4*)(rowp + bj * HALF) = pack8(acc[ai][bj][m][0] * rs, acc[ai][bj][m][1] * rs); }
        } else if (wc == 0) {
            f32x4 g0[2], g1[2], b0[2], b1[2];
#pragma unroll
            for (int n = 0; n < 2; ++n) { g0[n] = *(const f32x4*)(lng + 8 * fq + 4 * n); g1[n] = *(const f32x4*)(lng + 32 + 8 * fq + 4 * n); b0[n] = *(const f32x4*)(lnb + 8 * fq + 4 * n); b1[n] = *(const f32x4*)(lnb + 32 + 8 * fq + 4 * n); }
#pragma unroll
            for (int ai = 0; ai < 2; ++ai)
#pragma unroll
                for (int m = 0; m < 4; ++m) { const int row = row0 + ai * HALF + m * 16; const float rs = rsv[ai][m] * asc;
                    f32x4 v[2][2]; float s = 0.f;
#pragma unroll
                    for (int bj = 0; bj < 2; ++bj)
#pragma unroll
                        for (int n = 0; n < 2; ++n) { v[bj][n] = acc[ai][bj][m][n] * rs; s += (v[bj][n][0] + v[bj][n][1]) + (v[bj][n][2] + v[bj][n][3]); }
                    s += __shfl_xor(s, 16); s += __shfl_xor(s, 32);
                    const float mean = s * (1.0f / 64.0f); float q = 0.f;
#pragma unroll
                    for (int bj = 0; bj < 2; ++bj)
#pragma unroll
                        for (int n = 0; n < 2; ++n) { v[bj][n] = v[bj][n] - mean; q += (v[bj][n][0] * v[bj][n][0] + v[bj][n][1] * v[bj][n][1]) + (v[bj][n][2] * v[bj][n][2] + v[bj][n][3] * v[bj][n][3]); }
                    q += __shfl_xor(q, 16); q += __shfl_xor(q, 32);
                    const float rstd = 1.0f / sqrtf(q * (1.0f / 64.0f) + 1e-6f);
                    bf16_t* rowp = KI + (size_t)(row >> 5) * 2048 + (fq >> 1) * 512 + ((row & 31) + 32 * (fq & 1)) * 8;
                    *(u32x4*)(rowp) = pack8(v[0][0] * rstd * g0[0] + b0[0], v[0][1] * rstd * g0[1] + b0[1]);
                    *(u32x4*)(rowp + 1024) = pack8(v[1][0] * rstd * g1[0] + b1[0], v[1][1] * rstd * g1[1] + b1[1]); }
        } else if (wc == 1) {
            if (fq < 2) {
#pragma unroll
                for (int ai = 0; ai < 2; ++ai)
#pragma unroll
                    for (int m = 0; m < 4; ++m) { const int row = row0 + ai * HALF + m * 16; const float rs = rsv[ai][m] * 0.25f * asc; float* rowp = WI + (size_t)row * 16 + 8 * fq;
                        *(f32x4*)(rowp) = acc[ai][0][m][0] * rs; *(f32x4*)(rowp + 4) = acc[ai][0][m][1] * rs; }
            }
        }
    }
};
struct EpiGate {
    static constexpr bool PERM = true, AFTER_DRAIN = false; static constexpr int HOOK_T = -1;
    bf16_t* R; bf16_t* SB; long r_hi, sb_hi  ; const float* rstd0; float asc;
    __device__ __forceinline__ void hook(f32x4 (&)[2][2][4][2], const Unit&, int, int, int, int) const {}
    __device__ __forceinline__ void operator()(const f32x4 (&acc)[2][2][4][2], const Unit& u, int wr, int wc, int fr, int fq) const {
        const int row0 = u.pm * BM + wr * 64 + fr, col0 = u.pn * HALF + wc * 32 + 8 * fq;
        float rsv[2][4]; row_scalars(rstd0, row0, rsv);
        bf16_t* Rb = R + (u.pm >= 32 ? r_hi : 0L); bf16_t* Sb = SB + (u.pm >= 32 ? sb_hi : 0L);
#pragma unroll
        for (int ai = 0; ai < 2; ++ai)
#pragma unroll
            for (int m = 0; m < 4; ++m) { const int row = row0 + ai * HALF + m * 16; const float rs = rsv[ai][m] * asc; const size_t off = (size_t)row * 2048 + col0;
                f32x4 r0, r1, s0, s1;
                const float nrs = -1.4426950408889634f * rs;
#pragma unroll
                for (int j = 0; j < 4; ++j) { const float da0 = 1.0f + __builtin_amdgcn_exp2f(acc[ai][0][m][0][j] * nrs), da1 = 1.0f + __builtin_amdgcn_exp2f(acc[ai][0][m][1][j] * nrs);
                    const float db0 = 1.0f + fminf(__builtin_amdgcn_exp2f(acc[ai][1][m][0][j] * nrs), 1e20f), db1 = 1.0f + fminf(__builtin_amdgcn_exp2f(acc[ai][1][m][1][j] * nrs), 1e20f);
                    s0[j] = __builtin_amdgcn_rcpf(db0); s1[j] = __builtin_amdgcn_rcpf(db1);
                    r0[j] = db0 * __builtin_amdgcn_rcpf(da0); r1[j] = db1 * __builtin_amdgcn_rcpf(da1); }
                *(u32x4*)(Rb + off) = pack8(r0, r1); *(u32x4*)(Sb + off) = pack8(s0, s1); }
    }
};
template <int HT> struct EpiMerged {
    static constexpr bool PERM = true, AFTER_DRAIN = false; static constexpr int HOOK_T = HT;
    unsigned char* MG; const bf16_t* R; const bf16_t* SB; long r_hi, sb_hi  ; float osc;
    __device__ __forceinline__ void hook(f32x4 (&acc)[2][2][4][2], const Unit& u, int wr, int wc, int fr, int fq) const {
        unsigned o0 = (unsigned)(u.pm * BM + wr * 64 + fr) * 2048u + (unsigned)(u.pn * BM + wc * 32 + 8 * fq); asm volatile("" : "+v"(o0));
        const bf16_t* Rb = R + (u.pm >= 32 ? r_hi : 0L);
        u32x4 w[2][4][2];
#pragma unroll
        for (int ai = 0; ai < 2; ++ai)
#pragma unroll
            for (int m = 0; m < 4; ++m)
#pragma unroll
                for (int bj = 0; bj < 2; ++bj) w[ai][m][bj] = *(const u32x4*)(Rb + o0 + (unsigned)((ai * HALF + m * 16) * 2048) + bj * HALF);
#pragma unroll
        for (int ai = 0; ai < 2; ++ai)
#pragma unroll
            for (int m = 0; m < 4; ++m)
#pragma unroll
                for (int bj = 0; bj < 2; ++bj) { f32x4 a0, a1; unpack8(w[ai][m][bj], a0, a1); acc[ai][bj][m][0] *= a0; acc[ai][bj][m][1] *= a1; }
    }
    __device__ __forceinline__ void operator()(const f32x4 (&acc)[2][2][4][2], const Unit& u, int wr, int wc, int fr, int fq) const {
        unsigned o0 = (unsigned)(u.pm * BM + wr * 64 + fr) * 2048u + (unsigned)(u.pn * BM + wc * 32 + 8 * fq); asm volatile("" : "+v"(o0));
        const bf16_t* Sb = SB + (u.pm >= 32 ? sb_hi : 0L);
        u32x4 w[2][4][2];
#pragma unroll
        for (int ai = 0; ai < 2; ++ai)
#pragma unroll
            for (int m = 0; m < 4; ++m)
#pragma unroll
                for (int bj = 0; bj < 2; ++bj) w[ai][m][bj] = *(const u32x4*)(Sb + o0 + (unsigned)((ai * HALF + m * 16) * 2048) + bj * HALF);
        asm volatile("" ::: "memory");
#pragma unroll
        for (int ai = 0; ai < 2; ++ai)
#pragma unroll
            for (int m = 0; m < 4; ++m) { const unsigned o = o0 + (unsigned)((ai * HALF + m * 16) * 2048);
#pragma unroll
                for (int bj = 0; bj < 2; ++bj) { f32x4 b0, b1; unpack8(w[ai][m][bj], b0, b1);
                    const f32x4 v0 = acc[ai][bj][m][0] * b0 * osc, v1 = acc[ai][bj][m][1] * b1 * osc; typedef unsigned u32x2 __attribute__((ext_vector_type(2)));
                    *(u32x2*)(MG + o + bj * HALF) = (u32x2){pk4_fp8(v0[0], v0[1], v0[2], v0[3]), pk4_fp8(v1[0], v1[1], v1[2], v1[3])}; } }
    }
};
struct EpiResid {
    static constexpr bool PERM = true, AFTER_DRAIN = false; static constexpr int HOOK_T = -1;
    bf16_t* resb; float* ss; float asc;
    __device__ __forceinline__ void hook(f32x4 (&)[2][2][4][2], const Unit&, int, int, int, int) const {}
    __device__ __forceinline__ void operator()(const f32x4 (&acc)[2][2][4][2], const Unit& u, int wr, int wc, int fr, int fq) const {
        const int row0 = u.pm * BM + wr * 64 + fr;
        unsigned o0 = (unsigned)row0 * 2048u + (unsigned)(u.pn * BM + wc * 32 + 8 * fq); asm volatile("" : "+v"(o0));
        float sq[2][4];
        u32x4 rb[2][4][2];
#pragma unroll
        for (int ai = 0; ai < 2; ++ai)
#pragma unroll
            for (int m = 0; m < 4; ++m)
#pragma unroll
                for (int bj = 0; bj < 2; ++bj) rb[ai][m][bj] = *(const u32x4*)(resb + o0 + (unsigned)((ai * HALF + m * 16) * 2048) + bj * HALF);
        asm volatile("" ::: "memory");
#pragma unroll
        for (int ai = 0; ai < 2; ++ai)
#pragma unroll
            for (int m = 0; m < 4; ++m) { const unsigned o = o0 + (unsigned)((ai * HALF + m * 16) * 2048); float s = 0.f;
#pragma unroll
                for (int bj = 0; bj < 2; ++bj) { f32x4 r0, r1; unpack8(rb[ai][m][bj], r0, r1); const f32x4 v0 = r0 + acc[ai][bj][m][0] * asc, v1 = r1 + acc[ai][bj][m][1] * asc;
                    *(u32x4*)(resb + o + bj * HALF) = pack8(v0, v1);
                    s += (v0[0] * v0[0] + v0[1] * v0[1]) + (v0[2] * v0[2] + v0[3] * v0[3]) + (v1[0] * v1[0] + v1[1] * v1[1]) + (v1[2] * v1[2] + v1[3] * v1[3]); }
                s += __shfl_xor(s, 16); s += __shfl_xor(s, 32); sq[ai][m] = s; }
#pragma unroll
        for (int ai = 0; ai < 2; ++ai)
#pragma unroll
            for (int m = 0; m < 4; ++m) if (fq == 0) unsafeAtomicAdd(ss + row0 + ai * HALF + m * 16, sq[ai][m]);
    }
};
struct EpiUp {
    static constexpr bool PERM = true, AFTER_DRAIN = false; static constexpr int HOOK_T = -1;
    bf16_t* H; const float* ss1;
    __device__ __forceinline__ void hook(f32x4 (&)[2][2][4][2], const Unit&, int, int, int, int) const {}
    __device__ __forceinline__ void operator()(const f32x4 (&acc)[2][2][4][2], const Unit& u, int wr, int wc, int fr, int fq) const {
        const int row0 = u.pm * BM + wr * 64 + fr;
        bf16_t* base = H + (size_t)u.pm * (BM * 8192) + (size_t)(u.pn * 4 + (wc >> 1)) * (BM * 64) + (unsigned)(wr * 8192 + (wc & 1) * 1024 + ((fr * 64 + 16 * fq) ^ ((fr >> 3) << 5))) / 2u;
        float rsv[2][4]; row_scalars(ss1, row0, rsv);
#pragma unroll
        for (int ai = 0; ai < 2; ++ai)
#pragma unroll
            for (int m = 0; m < 4; ++m) { const float r2 = 1.0f / (rsv[ai][m] * (1.0f / 2048.0f) + 1e-6f); bf16_t* rowp = base + ai * 8192 + m * 1024;
#pragma unroll
                for (int bj = 0; bj < 2; ++bj) { f32x4 v0 = acc[ai][bj][m][0], v1 = acc[ai][bj][m][1];
#pragma unroll
                    for (int j = 0; j < 4; ++j) { const float a = fmaxf(v0[j], 0.f), b = fmaxf(v1[j], 0.f); v0[j] = a * a * r2; v1[j] = b * b * r2; }
                    *(u32x4*)(rowp + bj * (2 * BM * 64)) = pack8(v0, v1); } }
    }
};
template <class Epi, class Sched, bool ALIGN_EPI = false, bool SP2 = false, bool FP8 = false, bool ATILED = false>
__device__ __forceinline__ void gemm_phase(PG8_LAS unsigned char* lds, const Gemm g, const Sched& S, const Epi& E) {
    int tid_o = threadIdx.x; asm volatile("" : "+v"(tid_o));
    const int tid = tid_o, wid = __builtin_amdgcn_readfirstlane(tid >> 6), lane = tid & 63, wr = wid >> 2, wc = wid & 3, fr = lane & 15, fq = lane >> 4;
    const int K = g.K, nt = K / BK;
    unsigned voffA[2], voffB[2];
#pragma unroll
    for (int i = 0; i < 2; ++i) { int R, C; stage_rc(tid * 16 + i * 8192, R, C); const int Rb = Epi::PERM ? ((R & ~31) + perm32(R & 31)) : R;
        voffA[i] = ATILED ? (unsigned)(tid * 16 + i * 8192) : (unsigned)(R * K + C) * 2u; voffB[i] = (unsigned)(Rb * K + C) * 2u; }
    const size_t kstep = (size_t)(BK * 2);
    const size_t hstep = (size_t)HALF * K * 2;
    const size_t tstep = 2 * hstep;
    const size_t kstepA = ATILED ? (size_t)(BM * BK * 2) : kstep, hstepA = ATILED ? (size_t)(HALF * BK * 2) : hstep, pstepA = ATILED ? (size_t)(64 * BK * 2) : (size_t)64 * K * 2;
    const unsigned ldsw = (unsigned)wid * 1024u;
    const int aoff = lds_byte(wr * 64 + fr, fq * 8), boff = lds_byte(wc * 32 + fr, fq * 8);
#define PG8_SA(b, h) (((b) * 2 + (h)) * HTB)
#define PG8_SB(b, h) ((4 + (b) * 2 + (h)) * HTB)
#define PG8_STAGEX(bufoff, gbase, voff, pstep) do { _Pragma("unroll") for (int _i = 0; _i < 2; ++_i) { unsigned vo_ = (voff)[0]; asm volatile("" : "+v"(vo_)); \
        __builtin_amdgcn_global_load_lds((const unsigned*)((const char*)(gbase) + (size_t)_i * (pstep) + vo_), (PG8_LAS unsigned*)(lds + (bufoff) + ldsw + _i * 8192), 16, 0, 0); } } while (0)
#define PG8_STAGE(bufoff, gbase, voff) PG8_STAGEX(bufoff, gbase, voff, (size_t)64 * K * 2)
#define PG8_STAGEA(bufoff, gbase, voff) PG8_STAGEX(bufoff, gbase, voff, pstepA)
#define PG8_LDA(dst, b, h) do { _Pragma("unroll") for (int m = 0; m < 4; ++m) _Pragma("unroll") for (int k = 0; k < 2; ++k) dst[m][k] = *(const PG8_LAS bf16x8*)(lds + PG8_SA(b, h) + aoff + m * 2048 + k * 1024); } while (0)
#define PG8_LDB(dst, b, h) do { _Pragma("unroll") for (int n = 0; n < 2; ++n) _Pragma("unroll") for (int k = 0; k < 2; ++k) dst[n][k] = *(const PG8_LAS bf16x8*)(lds + PG8_SB(b, h) + boff + n * 2048 + k * 1024); } while (0)
#define PG8_F8(X) f8cat((X)[0], (X)[1])
#define PG8_MMA(ai, bj, At, Bt) do { __builtin_amdgcn_s_setprio(1); _Pragma("unroll") for (int m = 0; m < 4; ++m) _Pragma("unroll") for (int n = 0; n < 2; ++n) { \
        if constexpr (FP8) acc[ai][bj][m][n] = __builtin_amdgcn_mfma_scale_f32_16x16x128_f8f6f4(PG8_F8(Bt[n]), PG8_F8(At[m]), acc[ai][bj][m][n], 0, 0, 0, 0, 0, 0); \
        else { _Pragma("unroll") for (int k = 0; k < 2; ++k) acc[ai][bj][m][n] = __builtin_amdgcn_mfma_f32_16x16x32_bf16(Bt[n][k], At[m][k], acc[ai][bj][m][n], 0, 0, 0); } } __builtin_amdgcn_s_setprio(0); } while (0)
#define PG8_WAIT_V(n) asm volatile("s_waitcnt vmcnt(" #n ")" ::: "memory")
#define PG8_WAIT_L(n) asm volatile("s_waitcnt lgkmcnt(" #n ")" ::: "memory")
#define PG8_BAR __builtin_amdgcn_s_barrier()
#define PG8_SCHED __builtin_amdgcn_sched_barrier(0)
    Unit cur, nxt; int ui = 0;
    if (!S.next(0, cur)) return;
    cur.ui = 0;
    f32x4 acc[2][2][4][2];
#pragma unroll
    for (int a = 0; a < 2; ++a)
#pragma unroll
        for (int b = 0; b < 2; ++b)
#pragma unroll
            for (int m = 0; m < 4; ++m)
#pragma unroll
                for (int n = 0; n < 2; ++n) acc[a][b][m][n] = (f32x4){0.f, 0.f, 0.f, 0.f};
    bf16x8 At[4][2], B0[2][2], B1[2][2];
    const char* cA = (const char*)g.A + (size_t)cur.pm * tstep; const char* cB = (const char*)g.Bt + (size_t)cur.pn * tstep;
    S.a_ready(cur);
    if constexpr (SP2) {
        PG8_STAGE(PG8_SB(0, 0), cB, voffB); PG8_STAGE(PG8_SB(0, 1), cB + hstep, voffB); PG8_STAGEA(PG8_SA(0, 0), cA, voffA); PG8_STAGEA(PG8_SA(0, 1), cA + hstepA, voffA);
        if (wr == 1) PG8_BAR;
        PG8_WAIT_V(2); PG8_BAR;
        PG8_STAGE(PG8_SB(1, 0), cB + kstep, voffB); PG8_STAGEA(PG8_SA(1, 0), cA + kstepA, voffA); PG8_STAGE(PG8_SB(1, 1), cB + hstep + kstep, voffB);
        PG8_WAIT_V(6); PG8_BAR;
    } else {
        PG8_STAGE(PG8_SB(0, 0), cB, voffB); PG8_STAGEA(PG8_SA(0, 0), cA, voffA); PG8_STAGE(PG8_SB(0, 1), cB + hstep, voffB); PG8_STAGEA(PG8_SA(0, 1), cA + hstepA, voffA);
        if (wr == 1) PG8_BAR;
        PG8_WAIT_V(4); PG8_BAR;
        PG8_STAGE(PG8_SB(1, 0), cB + kstep, voffB); PG8_STAGEA(PG8_SA(1, 0), cA + kstepA, voffA); PG8_STAGE(PG8_SB(1, 1), cB + hstep + kstep, voffB);
        PG8_WAIT_V(6); PG8_BAR;
    }
    for (;;) {
        const bool has_next = S.next(ui + 1, nxt); nxt.ui = ui + 1;
        const char* nA = has_next ? (const char*)g.A + (size_t)nxt.pm * tstep : cA; const char* nB = has_next ? (const char*)g.Bt + (size_t)nxt.pn * tstep : cB;
        constexpr int NSEG = (Epi::HOOK_T >= 0) ? 2 : 1;
#pragma unroll 1
        for (int seg = 0; seg < NSEG; ++seg) {
        const int t_lo = (seg == 0) ? 0 : Epi::HOOK_T, t_hi = (NSEG == 2 && seg == 0) ? Epi::HOOK_T : nt;
        if (seg == 1) { int t_o = threadIdx.x; asm volatile("" : "+v"(t_o)); E.hook(acc, cur, wr, wc, t_o & 15, (t_o >> 4) & 3); }
#pragma unroll 1
        for (int t = t_lo; t < t_hi; t += 2) {
            const bool last = (t == nt - 2);
            const char* a1 = cA + (size_t)(t + 1) * kstepA;
            const char* a2 = last ? nA : cA + (size_t)(t + 2) * kstepA; const char* b2 = last ? nB : cB + (size_t)(t + 2) * kstep;
            const char* a3 = a2 + kstepA; const char* b3 = b2 + kstep;
            if (last && has_next) S.a_ready(nxt);
            if constexpr (SP2) {
            PG8_LDB(B0, 0, 0); PG8_LDB(B1, 0, 1); PG8_SCHED; PG8_LDA(At, 0, 0); PG8_STAGEA(PG8_SA(1, 1), a1 + hstepA, voffA);
            PG8_WAIT_V(8); PG8_WAIT_L(0); PG8_BAR; PG8_MMA(0, 0, At, B0); PG8_MMA(0, 1, At, B1); PG8_BAR; PG8_SCHED;
            PG8_LDA(At, 0, 1); PG8_STAGE(PG8_SB(0, 0), b2, voffB); PG8_STAGE(PG8_SB(0, 1), b2 + hstep, voffB); PG8_STAGEA(PG8_SA(0, 0), a2, voffA);
            PG8_WAIT_V(8); PG8_WAIT_L(0); PG8_BAR; PG8_MMA(1, 0, At, B0); PG8_MMA(1, 1, At, B1); PG8_BAR; PG8_SCHED;
            PG8_LDB(B0, 1, 0); PG8_LDB(B1, 1, 1); PG8_SCHED; PG8_LDA(At, 1, 0); PG8_STAGEA(PG8_SA(0, 1), a2 + hstepA, voffA);
            PG8_WAIT_V(8); PG8_WAIT_L(0); PG8_BAR; PG8_MMA(0, 0, At, B0); PG8_MMA(0, 1, At, B1); PG8_BAR; PG8_SCHED;
            PG8_LDA(At, 1, 1); PG8_STAGE(PG8_SB(1, 0), b3, voffB); PG8_STAGE(PG8_SB(1, 1), b3 + hstep, voffB); PG8_STAGEA(PG8_SA(1, 0), a3, voffA);
            PG8_WAIT_V(8); PG8_WAIT_L(0); PG8_BAR; PG8_MMA(1, 0, At, B0); PG8_MMA(1, 1, At, B1); PG8_BAR; PG8_SCHED;
            } else {
            PG8_LDB(B0, 0, 0); PG8_SCHED; PG8_LDA(At, 0, 0); PG8_STAGEA(PG8_SA(1, 1), a1 + hstepA, voffA);
            PG8_WAIT_L(8); PG8_BAR; PG8_WAIT_L(0); PG8_MMA(0, 0, At, B0); PG8_BAR; PG8_SCHED;
            PG8_LDB(B1, 0, 1); PG8_STAGE(PG8_SB(0, 0), b2, voffB);
            PG8_BAR; PG8_WAIT_L(0); PG8_MMA(0, 1, At, B1); PG8_BAR;
            PG8_LDA(At, 0, 1); PG8_STAGEA(PG8_SA(0, 0), a2, voffA);
            PG8_BAR; PG8_WAIT_L(0); PG8_MMA(1, 0, At, B0); PG8_BAR; PG8_SCHED;
            PG8_STAGE(PG8_SB(0, 1), b2 + hstep, voffB);
            PG8_WAIT_V(6); PG8_BAR; PG8_MMA(1, 1, At, B1); PG8_BAR;
            PG8_LDB(B0, 1, 0); PG8_SCHED; PG8_LDA(At, 1, 0); PG8_STAGEA(PG8_SA(0, 1), a2 + hstepA, voffA);
            PG8_WAIT_L(8); PG8_BAR; PG8_WAIT_L(0); PG8_MMA(0, 0, At, B0); PG8_BAR; PG8_SCHED;
            PG8_LDB(B1, 1, 1); PG8_STAGE(PG8_SB(1, 0), b3, voffB);
            PG8_BAR; PG8_WAIT_L(0); PG8_MMA(0, 1, At, B1); PG8_BAR;
            PG8_LDA(At, 1, 1); PG8_STAGEA(PG8_SA(1, 0), a3, voffA);
            PG8_BAR; PG8_WAIT_L(0); PG8_MMA(1, 0, At, B0); PG8_BAR; PG8_SCHED;
            PG8_STAGE(PG8_SB(1, 1), b3 + hstep, voffB);
            PG8_WAIT_V(6); PG8_BAR; PG8_MMA(1, 1, At, B1); PG8_BAR;
            }
        }
        }
        if constexpr (ALIGN_EPI) { if (wr == 0) PG8_BAR; }
        if constexpr (!Epi::AFTER_DRAIN) { int t_o = threadIdx.x; asm volatile("" : "+v"(t_o)); E(acc, cur, wr, wc, t_o & 15, (t_o >> 4) & 3); S.done(cur); }
        if (!has_next) break;
#pragma unroll
        for (int a = 0; a < 2; ++a)
#pragma unroll
            for (int b = 0; b < 2; ++b)
#pragma unroll
                for (int m = 0; m < 4; ++m)
#pragma unroll
                    for (int n = 0; n < 2; ++n) acc[a][b][m][n] = (f32x4){0.f, 0.f, 0.f, 0.f};
        cur = nxt; cA = nA; cB = nB; ++ui;
        if constexpr (ALIGN_EPI) { if (wr == 1) PG8_BAR; }
    }
    PG8_WAIT_V(0);
    if constexpr (!ALIGN_EPI) { if (wr == 0) PG8_BAR; }
    PG8_BAR;
    if constexpr (Epi::AFTER_DRAIN) { E.fused(acc, cur, wr, wc, fr, fq, lds, wid, lane); S.done(cur); }
#undef PG8_SA
#undef PG8_SB
#undef PG8_STAGE
#undef PG8_STAGEA
#undef PG8_STAGEX
#undef PG8_LDA
#undef PG8_LDB
#undef PG8_MMA
#undef PG8_F8
#undef PG8_WAIT_V
#undef PG8_WAIT_L
#undef PG8_BAR
#undef PG8_SCHED
}
}

constexpr int NWAVES = 8;
constexpr int BATCH = 8, SEQ = 2048, DM = 2048, DFF = 8192, M = BATCH * SEQ;
constexpr int D_IN = 12880, NQKV = 5120  , NQKV_W = 7680  , N1I = 1280  , N1 = NQKV_W + N1I, NG = 4096, N1T = N1 + NG;
constexpr int KP = 1536;
constexpr float LOG2E = 1.4426950408889634f;
constexpr float QK_C = 0.088388347648318440f * LOG2E;
constexpr float NEGV = -1e30f;
constexpr int NPH = 11;
#ifndef STAGGER_TICKS
#define STAGGER_TICKS 500
#endif
constexpr float W8_SCALE = 64.f, WP8_SCALE = 32.f, O8_SCALE = 16.f;

constexpr size_t MiB = 1u << 20;
constexpr size_t WS_CTL = 0, CTL_ZERO_BYTES = 1 * MiB;
constexpr size_t WS_W1Q8 = 1 * MiB, WS_W1G8 = 16 * MiB, WS_W1I = 24 * MiB, WS_WP8 = 29 * MiB, WS_WO8 = 32 * MiB, WS_WU = 36 * MiB, WS_WD = 68 * MiB;
constexpr size_t WS_X8 = 100 * MiB;
constexpr size_t WS_XB = 132 * MiB;
constexpr size_t WS_BIG = 196 * MiB;
constexpr size_t WS_QKV = WS_BIG, WS_KAF = WS_BIG + 160 * MiB, WS_KBF = WS_BIG + 208 * MiB, WS_QI = WS_BIG + 240 * MiB, WS_KI = WS_BIG + 272 * MiB, WS_WI = WS_BIG + 274 * MiB, WS_MASK = WS_BIG + 275 * MiB;
constexpr size_t WS_MG8 = WS_BIG + 128 * MiB, WS_H = WS_BIG;
constexpr size_t WS_R_LO = WS_KAF, WS_R_HI = WS_QI, WS_SB_LO = WS_BIG + 279 * MiB, G_HALF_BYTES = (size_t)(M / 2) * DM * 2;
constexpr size_t WS_END = 512 * MiB;
static_assert(WS_W1Q8 + (size_t)NQKV_W * DM <= WS_W1G8 && WS_W1G8 + (size_t)NG * DM <= WS_W1I && WS_W1I + (size_t)N1I * DM * 2 <= WS_WP8 && WS_WP8 + (size_t)DM * KP <= WS_WO8 && WS_WO8 + (size_t)DM * DM <= WS_WU && WS_WU + (size_t)DFF * DM * 2 <= WS_WD && WS_WD + (size_t)DM * DFF * 2 <= WS_X8 && WS_X8 + (size_t)M * DM <= WS_XB, "weights map");
static_assert(WS_XB + (size_t)M * DM * 2 <= WS_BIG && WS_QKV + (size_t)M * NQKV * 2 <= WS_KAF && WS_KAF + (size_t)M * 1536 * 2 <= WS_KBF && WS_KBF + (size_t)M * 1024 * 2 <= WS_QI && WS_QI + (size_t)M * 1024 * 2 <= WS_KI && WS_KI + (size_t)M * 64 * 2 <= WS_WI && WS_WI + (size_t)M * 16 * 4 <= WS_MASK && WS_MASK + (size_t)M * 64 * 4 <= WS_END, "activation map");
static_assert(WS_MG8 + (size_t)M * DM <= WS_KAF && WS_H + (size_t)M * DFF * 2 <= WS_END && WS_R_LO + G_HALF_BYTES <= WS_KBF && WS_R_HI + G_HALF_BYTES <= WS_KI && WS_MASK + (size_t)M * 64 * 4 <= WS_SB_LO && WS_SB_LO + G_HALF_BYTES <= WS_END, "overlay map");
constexpr size_t DO_OAP = 0, DO_LSE = 48 * MiB, DO_OAB = 64 * MiB, DO_SB_HI = 88 * MiB  ;
constexpr int CW_BAR = 4096;
constexpr size_t CTL_SS1 = 256 * 1024, CTL_SS2 = 320 * 1024, CTL_RSTD0 = 384 * 1024, CTL_PCNT = 448 * 1024;

constexpr int RING_BYTES = 131072;
constexpr int LDSCTL_OFF = 151552, MISC_OFF = LDSCTL_OFF + 320;
constexpr int LDS_BYTES = 155648;

#define GAS __attribute__((address_space(1)))
#define LAS __attribute__((address_space(3)))
typedef unsigned short bf16;
typedef unsigned v4u __attribute__((ext_vector_type(4)));
typedef float f32x4 __attribute__((ext_vector_type(4)));
typedef float f32x16 __attribute__((ext_vector_type(16)));
typedef short bf16x8 __attribute__((ext_vector_type(8)));
typedef short s16x4 __attribute__((ext_vector_type(4)));
typedef GAS unsigned gu32;
#define LDS_WAIT() asm volatile("s_waitcnt lgkmcnt(0)" ::: "memory")
#define VM_WAIT() asm volatile("s_waitcnt vmcnt(0)" ::: "memory")
#define SBAR() __builtin_amdgcn_sched_barrier(0)
__device__ __forceinline__ unsigned f2bf(float f) { unsigned u = __builtin_bit_cast(unsigned, f); return (u + 0x7fffu + ((u >> 16) & 1u)) >> 16; }
__device__ __forceinline__ unsigned pk2(float lo, float hi) { return f2bf(lo) | (f2bf(hi) << 16); }
__device__ __forceinline__ unsigned cvtpk(float lo, float hi) { unsigned r; asm volatile("v_cvt_pk_bf16_f32 %0, %1, %2" : "=v"(r) : "v"(lo), "v"(hi)); return r; }
__device__ __forceinline__ int crow(int r, int hi) { return (r & 3) + 8 * (r >> 2) + 4 * hi; }
__device__ __forceinline__ float wave_sum(float v) {
#pragma unroll
    for (int o = 1; o < 64; o <<= 1) v += __shfl_xor(v, o);
    return v;
}
__device__ __forceinline__ int t5_bucket(int n) {
    if (n < 16) return n;
    const int l = 16 + (int)(logf((float)n / 16.0f) / 4.852030263919617f * 16.0f);
    return l < 31 ? l : 31;
}
#define XB_TMO      128
#define XB_XCNT(j)  (256  + 64 * (j))
#define XB_XSUB(j)  (1280 + 64 * (j))
#define XB_XGEN(j)  (2304 + 64 * (j))
#define XB_TOP      3328
#define XB_TOPGEN   3392
#define XCD_BAR_WORDS 3456
#define XB_SPIN_CAP (1u << 18)

__device__ __forceinline__ unsigned xb_ld(unsigned* p)              { return __hip_atomic_load(p, __ATOMIC_RELAXED, __HIP_MEMORY_SCOPE_AGENT); }
__device__ __forceinline__ unsigned xb_add(unsigned* p, unsigned v) { return __hip_atomic_fetch_add(p, v, __ATOMIC_RELAXED, __HIP_MEMORY_SCOPE_AGENT); }
__device__ __forceinline__ unsigned xb_xcc_id() { return (unsigned)__builtin_amdgcn_s_getreg((3 << 11) | 20) & 0xFu; }
#define XB_SPIN(cond, bar) do { unsigned _sp = 0; while (cond) { __builtin_amdgcn_s_sleep(1); \
    if ((++_sp & 255u) == 0u) { if (xb_ld(&(bar)[XB_TMO])) break; if (_sp > XB_SPIN_CAP) { atomicAdd(&(bar)[XB_TMO], 1u); break; } } } } while (0)

struct XcdBarrier {
    unsigned* bar; unsigned x; unsigned G;
    volatile LAS unsigned* st;
};

__device__ __forceinline__ XcdBarrier xcd_barrier_post(unsigned* bar, volatile LAS unsigned* st) {
    XcdBarrier b; b.bar = bar; b.x = xb_xcc_id(); b.st = st;
    if (threadIdx.x == 0) (void)xb_add(&bar[XB_XCNT(b.x)], 1u);
    return b;
}
__device__ __forceinline__ void xcd_barrier_complete(unsigned* bar, unsigned x, unsigned& nloc, unsigned& nx, unsigned xb_grid) {
    const unsigned G = xb_grid;
    unsigned sum, cnt, mine, sp = 0u;
    for (;;) {
        sum = 0u; cnt = 0u; mine = 0u;
#pragma unroll
        for (unsigned j = 0; j < 16; ++j) { const unsigned c = xb_ld(&bar[XB_XCNT(j)]); sum += c; cnt += (c > 0u) ? 1u : 0u; mine = (j == x) ? c : mine; }
        if (sum == G) break;
        __builtin_amdgcn_s_sleep(1);
        if ((++sp & 255u) == 0u) { if (xb_ld(&bar[XB_TMO])) break; if (sp > XB_SPIN_CAP) { atomicAdd(&bar[XB_TMO], 1u); break; } }
    }
    nloc = mine > 0u ? mine : 1u; nx = cnt > 0u ? cnt : 1u;
}

__device__ __forceinline__ void xcd_barrier(const XcdBarrier& b) {
    asm volatile("s_waitcnt vmcnt(0)" ::: "memory");
    __syncthreads();
    if (threadIdx.x == 0) {
        unsigned* bar = b.bar;
        __builtin_amdgcn_s_waitcnt(0);
        unsigned nloc = b.st[0], nx = b.st[1];
        if (nloc == 0u) { xcd_barrier_complete(bar, b.x, nloc, nx, b.G); b.st[0] = nloc; b.st[1] = nx; }
        const unsigned old = xb_add(&bar[XB_XSUB(b.x)], 1u);
        const unsigned gen = old / nloc;
        if (old + 1u == (gen + 1u) * nloc) {
            __builtin_amdgcn_fence(__ATOMIC_RELEASE, "agent");
            asm volatile("s_waitcnt vmcnt(0)" ::: "memory");
            const unsigned og = xb_add(&bar[XB_TOP], 1u);
            const unsigned tg = og / nx;
            if (og + 1u == (tg + 1u) * nx) xb_add(&bar[XB_TOPGEN], 1u);
            else XB_SPIN(xb_ld(&bar[XB_TOPGEN]) == tg, bar);
            __builtin_amdgcn_fence(__ATOMIC_ACQUIRE, "agent");
            xb_add(&bar[XB_XGEN(b.x)], 1u);
            asm volatile("s_waitcnt vmcnt(0)" ::: "memory");
        } else {
            XB_SPIN(xb_ld(&bar[XB_XGEN(b.x)]) == gen, bar);
            __builtin_amdgcn_fence(__ATOMIC_ACQUIRE, "agent");
            asm volatile("s_waitcnt vmcnt(0)" ::: "memory");
        }
    }
    __syncthreads();
}

struct Frame {
    LAS unsigned char* lds;
    volatile LAS unsigned* MISC;
    gu32* ctl;
    int tid, lane, wave, vcu, G;
};

__device__ __forceinline__ unsigned pk4_fp8(float a, float b, float c, float d) { int v = 0; v = __builtin_amdgcn_cvt_pk_fp8_f32(a, b, v, false); v = __builtin_amdgcn_cvt_pk_fp8_f32(c, d, v, true); return (unsigned)v; }
template <bool F8>
__device__ __forceinline__ void p0_transpose_item(const float* __restrict__ W, int ldw, const float* __restrict__ gk, float scale, void* __restrict__ WTv, int ldt, int koff, int k0, int n0, int srccol4, LAS float* scr, int lane) {
    const int nq = lane & 15, kr = lane >> 4;
    f32x4 v[16];
#pragma unroll
    for (int i = 0; i < 16; ++i) { v[i] = (f32x4){0.f, 0.f, 0.f, 0.f}; if (srccol4 >= 0) v[i] = __builtin_nontemporal_load((const GAS f32x4*)(W + (size_t)(k0 + 4 * i + kr) * ldw + srccol4)); }
#pragma unroll
    for (int i = 0; i < 16; ++i) v[i] = v[i] * (gk ? gk[k0 + 4 * i + kr] * scale : scale);
#pragma unroll
    for (int i = 0; i < 16; ++i) *(LAS f32x4*)(scr + (4 * i + kr) * 68 + 4 * nq) = v[i];
    LDS_WAIT(); asm volatile("" ::: "memory");
    if constexpr (!F8) { bf16* WT = (bf16*)WTv; const int c = lane & 7;
#pragma unroll
        for (int j = 0; j < 8; ++j) { const int n = (lane >> 3) + 8 * j; const LAS float* s = scr + (8 * c) * 68 + n;
            v4u o; o.x = pk2(s[0 * 68], s[1 * 68]); o.y = pk2(s[2 * 68], s[3 * 68]); o.z = pk2(s[4 * 68], s[5 * 68]); o.w = pk2(s[6 * 68], s[7 * 68]);
            __builtin_nontemporal_store(o, (GAS v4u*)(WT + (size_t)(n0 + n) * ldt + koff + k0 + 8 * c)); }
    } else { unsigned char* WT = (unsigned char*)WTv; const int c = lane & 3;
#pragma unroll
        for (int j = 0; j < 4; ++j) { const int n = (lane >> 2) + 16 * j; const LAS float* s = scr + (16 * c) * 68 + n;
            v4u o; o.x = pk4_fp8(s[0 * 68], s[1 * 68], s[2 * 68], s[3 * 68]); o.y = pk4_fp8(s[4 * 68], s[5 * 68], s[6 * 68], s[7 * 68]); o.z = pk4_fp8(s[8 * 68], s[9 * 68], s[10 * 68], s[11 * 68]); o.w = pk4_fp8(s[12 * 68], s[13 * 68], s[14 * 68], s[15 * 68]);
            __builtin_nontemporal_store(o, (GAS v4u*)(WT + (size_t)(n0 + n) * ldt + koff + k0 + 16 * c)); }
    }
    LDS_WAIT(); asm volatile("" ::: "memory");
}
__device__ __forceinline__ int w1_srccol(int n) {
    if (n < 8704) return n;
    if (n < N1) { const int c = n - 8704; if (c < 32) return 8704 + c; if (c < 48) return 8768 + (c - 32); if (c >= 128 && c < 160) return 8704 + 32 + (c - 128); return -1; }
    { const int c = n - N1; return 8784 + ((c >> 7) & 1) * 2048 + (c >> 8) * 128 + (c & 127); }
}
struct P0Args { const float *x, *g_mix, *w_in, *w_pa, *w_pb, *w_out, *g_mlp, *w_up, *w_dn; unsigned char *W1Q8, *W1G8; bf16* W1I; unsigned char *WP8, *WO8; bf16 *WUt, *WDt, *XB; unsigned char* X8; float* rstd0; };
template <bool DEFERRED>
__device__ __forceinline__ void p0_prologue(Frame& F, const P0Args& A) {
    LAS float* scr = (LAS float*)(F.lds + F.wave * 17408);
    const int gw = F.vcu * NWAVES + F.wave, NGW = F.G * NWAVES;
    constexpr int I_E = (DM / 64) * (N1 / 64), I_G = (DM / 64) * (NG / 64), I_PA = (512 / 64) * (DM / 64), I_PB = (1024 / 64) * (DM / 64), I_O = (DM / 64) * (DM / 64), I_U = (DM / 64) * (DFF / 64), I_D = (DFF / 64) * (DM / 64);
    constexpr int NITEMS = DEFERRED ? I_G + I_PA + I_PB + I_O + I_U + I_D : I_E;
    const int nq4 = 4 * (F.lane & 15);
    for (int it = gw; it < NITEMS; it += NGW) {
        int r = it;
        if constexpr (!DEFERRED) { const int nb = N1 / 64, kb = r / nb, n0 = 64 * (r % nb); const int sc4 = w1_srccol(n0 + nq4);
            if (n0 < NQKV_W) p0_transpose_item<true>(A.w_in, D_IN, A.g_mix, W8_SCALE, A.W1Q8, DM, 0, 64 * kb, n0, sc4, scr, F.lane);
            else p0_transpose_item<false>(A.w_in, D_IN, A.g_mix, 1.f, A.W1I, DM, 0, 64 * kb, n0 - NQKV_W, sc4, scr, F.lane);
        } else {
        if (r < I_G) { const int nb = NG / 64, kb = r / nb, n0 = 64 * (r % nb); p0_transpose_item<true>(A.w_in, D_IN, A.g_mix, W8_SCALE, A.W1G8, DM, 0, 64 * kb, n0, w1_srccol(N1 + n0 + nq4), scr, F.lane); continue; } r -= I_G;
        if (r < I_PA) { const int nb = DM / 64, kb = r / nb, n0 = 64 * (r % nb); p0_transpose_item<true>(A.w_pa, DM, nullptr, WP8_SCALE, A.WP8, KP, 0, 64 * kb, n0, n0 + nq4, scr, F.lane); continue; } r -= I_PA;
        if (r < I_PB) { const int nb = DM / 64, kb = r / nb, n0 = 64 * (r % nb); p0_transpose_item<true>(A.w_pb, DM, nullptr, WP8_SCALE, A.WP8, KP, 512, 64 * kb, n0, n0 + nq4, scr, F.lane); continue; } r -= I_PB;
        if (r < I_O) { const int nb = DM / 64, kb = r / nb, n0 = 64 * (r % nb); p0_transpose_item<true>(A.w_out, DM, nullptr, W8_SCALE, A.WO8, DM, 0, 64 * kb, n0, n0 + nq4, scr, F.lane); continue; } r -= I_O;
        if (r < I_U) { const int nb = DFF / 64, kb = r / nb, n0 = 64 * (r % nb); p0_transpose_item<false>(A.w_up, DFF, A.g_mlp, 1.f, A.WUt, DM, 0, 64 * kb, n0, n0 + nq4, scr, F.lane); continue; } r -= I_U;
        { const int nb = DM / 64, kb = r / nb, n0 = 64 * (r % nb); p0_transpose_item<false>(A.w_dn, DM, nullptr, 1.f, A.WDt, DFF, 0, 64 * kb, n0, n0 + nq4, scr, F.lane); }
        }
    }
    if constexpr (DEFERRED) return;
    for (int m = gw; m < M; m += NGW) {
        const GAS f32x4* xr = (const GAS f32x4*)(A.x + (size_t)m * DM) + F.lane; f32x4 v[8]; float s = 0.f;
#pragma unroll
        for (int j = 0; j < 8; ++j) { v[j] = __builtin_nontemporal_load(xr + 64 * j); s += (v[j].x * v[j].x + v[j].y * v[j].y) + (v[j].z * v[j].z + v[j].w * v[j].w); }
        s = wave_sum(s);
        GAS unsigned long long* o8 = (GAS unsigned long long*)(A.XB + (size_t)m * DM) + F.lane; GAS unsigned* o4 = (GAS unsigned*)(A.X8 + (size_t)m * DM) + F.lane;
#pragma unroll
        for (int j = 0; j < 8; ++j) { o8[64 * j] = (unsigned long long)pk2(v[j].x, v[j].y) | ((unsigned long long)pk2(v[j].z, v[j].w) << 32); o4[64 * j] = pk4_fp8(v[j].x, v[j].y, v[j].z, v[j].w); }
        if (F.lane == 0) A.rstd0[m] = 1.0f / sqrtf(s * (1.0f / DM) + 1e-6f);
    }
}

__device__ __forceinline__ int half32_sum_i(int v, int hi) {
    v += __builtin_amdgcn_update_dpp(0, v, 0xB1, 0xF, 0xF, true);
    v += __builtin_amdgcn_update_dpp(0, v, 0x4E, 0xF, 0xF, true);
    v += __builtin_amdgcn_update_dpp(0, v, 0x141, 0xF, 0xF, true);
    v += __builtin_amdgcn_update_dpp(0, v, 0x140, 0xF, 0xF, true);
    const int t0 = __builtin_amdgcn_readlane(v, 0) + __builtin_amdgcn_readlane(v, 16), t1 = __builtin_amdgcn_readlane(v, 32) + __builtin_amdgcn_readlane(v, 48);
    return hi ? t1 : t0;
}
__device__ __forceinline__ float relu_i(float x) { const int b = __float_as_int(x); return __int_as_float(b > 0 ? b : 0); }
__device__ __forceinline__ void index_unit(const bf16* __restrict__ QI, const bf16* __restrict__ KI, const float* __restrict__ WI, unsigned* __restrict__ MASK, int b, int t0, int lane) {
    const int rho = lane & 31, hi = lane >> 5;
    const size_t tb = (size_t)b * SEQ;
    bf16x8 a[4];
    { const bf16* ap = QI + (tb + t0 + ((rho >> 2) & 1)) * 1024 + ((rho & 3) + 4 * (rho >> 3)) * 64 + 8 * hi;
#pragma unroll
      for (int ks = 0; ks < 4; ++ks) a[ks] = *(const bf16x8*)(ap + 16 * ks); }
    float w[16];
    { const f32x4* wp = (const f32x4*)(WI + (tb + t0 + hi) * 16);
#pragma unroll
      for (int i = 0; i < 4; ++i) { const f32x4 v = wp[i]; w[4 * i] = v[0]; w[4 * i + 1] = v[1]; w[4 * i + 2] = v[2]; w[4 * i + 3] = v[3]; } }
    const int nkb = (t0 + 1) / 32 + 1;
    const bf16* kbase = KI + (tb >> 5) * 2048;
    unsigned kloff = (unsigned)lane * 8u; asm volatile("" : "+v"(kloff));
    const int tq = t0 + hi;
    float sc[64];
    bf16x8 bq[2][2][4];
    const int np = (nkb + 1) >> 1;
#define IDX_LOADP(slot, pp_) do { const bf16* kp_ = kbase + (size_t)(pp_) * 4096; _Pragma("unroll") for (int e = 0; e < 2; ++e) _Pragma("unroll") for (int ks = 0; ks < 4; ++ks) bq[slot][e][ks] = *(const bf16x8*)(kp_ + 2048 * e + 512 * ks + kloff); } while (0)
    IDX_LOADP(0, 0);
#pragma unroll
    for (int pp = 0; pp < 32; ++pp) {
        sc[2 * pp] = -FLT_MAX; sc[2 * pp + 1] = -FLT_MAX;
        if (pp < np) {
            if (pp + 1 < np) IDX_LOADP((pp + 1) & 1, pp + 1);
            f32x16 c0 = {}, c1 = {};
#pragma unroll
            for (int ks = 0; ks < 4; ++ks) c0 = __builtin_amdgcn_mfma_f32_32x32x16_bf16(a[ks], bq[pp & 1][0][ks], c0, 0, 0, 0);
            float s0, s1;
            { typedef float f32x2 __attribute__((ext_vector_type(2)));
              f32x2 p0a = {0.f, 0.f}, p0b = {0.f, 0.f}, p1a = {0.f, 0.f}, p1b = {0.f, 0.f};
#define RELU_I(x) relu_i(x)
#pragma unroll
              for (int ks = 0; ks < 4; ++ks) { const int r = 4 * ks;
                  c1 = __builtin_amdgcn_mfma_f32_32x32x16_bf16(a[ks], bq[pp & 1][1][ks], c1, 0, 0, 0);
                  __builtin_amdgcn_sched_barrier(0);
                  { const f32x2 wa = {w[r], w[r + 1]}, wb = {w[r + 2], w[r + 3]};
                    p0a = __builtin_elementwise_fma((f32x2){RELU_I(c0[r]), RELU_I(c0[r + 1])}, wa, p0a); p0b = __builtin_elementwise_fma((f32x2){RELU_I(c0[r + 2]), RELU_I(c0[r + 3])}, wb, p0b); }
                  __builtin_amdgcn_sched_barrier(0); }
#pragma unroll
              for (int r = 0; r < 16; r += 4) { const f32x2 wa = {w[r], w[r + 1]}, wb = {w[r + 2], w[r + 3]};
                  p1a = __builtin_elementwise_fma((f32x2){RELU_I(c1[r]), RELU_I(c1[r + 1])}, wa, p1a); p1b = __builtin_elementwise_fma((f32x2){RELU_I(c1[r + 2]), RELU_I(c1[r + 3])}, wb, p1b); }
#undef RELU_I
              s0 = (p0a[0] + p0a[1]) + (p0b[0] + p0b[1]); s1 = (p1a[0] + p1a[1]) + (p1b[0] + p1b[1]); }
            sc[2 * pp] = (pp * 64 + rho <= tq) ? s0 : -FLT_MAX; sc[2 * pp + 1] = (pp * 64 + 32 + rho <= tq) ? s1 : -FLT_MAX;
        }
    }
#undef IDX_LOADP
    float mx, mn;
    { float mxp[4] = {-FLT_MAX, -FLT_MAX, -FLT_MAX, -FLT_MAX}, mnp[4] = {FLT_MAX, FLT_MAX, FLT_MAX, FLT_MAX};
#pragma unroll
      for (int q = 0; q < 8; ++q) if (8 * q < nkb) {
#pragma unroll
          for (int kb = 8 * q; kb < 8 * q + 8; ++kb) { const float v = sc[kb]; mxp[kb & 3] = fmaxf(mxp[kb & 3], v); mnp[kb & 3] = (v > -FLT_MAX) ? fminf(mnp[kb & 3], v) : mnp[kb & 3]; } }
      mx = fmaxf(fmaxf(mxp[0], mxp[1]), fmaxf(mxp[2], mxp[3])); mn = fminf(fminf(mnp[0], mnp[1]), fminf(mnp[2], mnp[3])); }
#pragma unroll
    for (int o = 1; o < 32; o <<= 1) { mx = fmaxf(mx, __shfl_xor(mx, o)); mn = fminf(mn, __shfl_xor(mn, o)); }
    float lo = mn, hb = mx, thr = mn; bool done = (tq + 1 <= 256);
    if (done) thr = -3.0e38f;
    float flo = (float)(tq + 1) - 256.5f, fhb = 1.0f - 256.5f; int side = 0;
    for (int it = 0; it < 96; ++it) {
        if (__all(done)) break;
        float tfr = flo * __builtin_amdgcn_rcpf(flo - fhb);
        tfr = fminf(fmaxf(tfr, 0.02f), 0.98f);
        const float mid = lo + (hb - lo) * tfr;
        const bool stuck = !(mid > lo) || !(mid < hb);
        int cn = 0;
#pragma unroll
        for (int q = 0; q < 8; ++q) if (8 * q < nkb) {
#pragma unroll
            for (int kb = 8 * q; kb < 8 * q + 8; ++kb) cn += (sc[kb] >= mid) ? 1 : 0; }
        const int c = half32_sum_i(cn, hi);
        if (!done) {
            if (stuck) { thr = lo; done = true; }
            else if (c == 256) { thr = mid; done = true; }
            else if (c > 256) { lo = mid; flo = (float)c - 256.5f; if (side > 0) fhb *= 0.5f; side = 1; } else { hb = mid; fhb = (float)c - 256.5f; if (side < 0) flo *= 0.5f; side = -1; }
        }
    }
    if (!done) thr = lo;
    unsigned w0 = 0u, w1 = 0u;
    int lane_o = lane;
#pragma unroll
    for (int q = 0; q < 8; ++q) if (8 * q < nkb) {
#pragma unroll
      for (int kb = 8 * q; kb < 8 * q + 8; ++kb) { const unsigned long long bal = __ballot(sc[kb] >= thr); const unsigned blo = (unsigned)bal, bhi = (unsigned)(bal >> 32);
        w0 = (lane_o == kb) ? blo : w0; w1 = (lane_o == kb) ? bhi : w1;
        asm volatile("" : "+v"(w0), "+v"(w1), "+v"(lane_o)); } }
    MASK[(tb + t0) * 64 + lane] = w0; MASK[(tb + t0 + 1) * 64 + lane] = w1;
}

#define KSWZ(row, colB) ((row) * 256 + ((colB) ^ (((row) & 7) << 4)))
__device__ __forceinline__ int v_st(int k, int c) { const int kk = (k & ~0xC) | ((k & 4) << 1) | ((k & 8) >> 1); return ((kk >> 3) * 4 + (c >> 5)) * 512 + ((kk & 7) * 32 + (c & 31)) * 2; }
__device__ __forceinline__ int v_rd_base(int lane) { return ((lane & 3) << 3) | (((lane >> 2) & 3) << 6) | (((lane >> 4) & 1) << 5) | (((lane >> 5) & 1) << 8); }
constexpr int v_rd_off(int d0, int ks, int half) { return d0 * 512 + ks * 4096 + half * 2048; }
template <int OFF> __device__ __forceinline__ s16x4 tr_read(int vb) { s16x4 r; asm volatile("ds_read_b64_tr_b16 %0, %1 offset:%2" : "=&v"(r) : "v"(vb), "i"(OFF) : "memory"); return r; }
#define PKV(L, H) (bf16x8){L[0], L[1], L[2], L[3], H[0], H[1], H[2], H[3]}
#define PK4(P, BASE, OUT) do { unsigned a0_ = cvtpk(P[BASE + 0], P[BASE + 1]), a1_ = cvtpk(P[BASE + 2], P[BASE + 3]);   \
    unsigned b0_ = cvtpk(P[BASE + 4], P[BASE + 5]), b1_ = cvtpk(P[BASE + 6], P[BASE + 7]);                              \
    auto r0_ = __builtin_amdgcn_permlane32_swap(a0_, b0_, false, false); auto r1_ = __builtin_amdgcn_permlane32_swap(a1_, b1_, false, false); \
    v4u w_ = {r0_[0], r1_[0], r0_[1], r1_[1]}; OUT = __builtin_bit_cast(bf16x8, w_); } while (0)
__device__ __forceinline__ float half_max(float v) { auto rr = __builtin_amdgcn_permlane32_swap(__float_as_uint(v), __float_as_uint(v), false, false); return fmaxf(__uint_as_float(rr[0]), __uint_as_float(rr[1])); }
__device__ __forceinline__ float half_sum(float v) { auto rr = __builtin_amdgcn_permlane32_swap(__float_as_uint(v), __float_as_uint(v), false, false); return __uint_as_float(rr[0]) + __uint_as_float(rr[1]); }
__device__ __forceinline__ int lds_addr(const LAS void* p) { return (int)(unsigned)(uintptr_t)p; }

constexpr int WL_V = 0, WL_Q = 8192, WL_X = 16384, WL_BYTES = 16384 + 512;
constexpr int TABA_N = 192, TABB_N = 2112;
template <int MODE> struct WUnit {
    const bf16* qp; const bf16* kp; const bf16* vp;
    int dsh, r, p0; const LAS float* tab; const unsigned* mrow;
    LAS unsigned char* wl; int lane;
};
template <int MODE>
__device__ __forceinline__ void wu_block(const WUnit<MODE>& U, bf16x8 (&kc)[8], bf16x8 (&vs)[8], unsigned& mwr, bool has_next, int ps, int pn  , f32x16 (&o)[4], float& m_run, float& l_run) {
    const int q = U.lane & 31, hi = U.lane >> 5, vkey0 = U.lane >> 4, vcol = (U.lane & 15) * 8;
    const unsigned mw = mwr; (void)mw;
    static_assert(MODE == 0, "wu_block: the dilated-window path only (the bitmask path was replaced by the dense mixer-B body)");
    const int jb = U.p0 - ps + q - 4 * hi;
    const LAS float* tq_ = U.tab + (TABA_N - 1 - 32) - jb;
    const float mref = (m_run == NEGV) ? 0.f : m_run;
    f32x16 p, p2 = {};
#pragma unroll
    for (int rr = 0; rr < 16; ++rr) { const int cr = (rr & 3) + 8 * (rr >> 2); p[rr] = tq_[cr] - mref; }
#pragma unroll
    for (int d0 = 0; d0 < 8; d0 += 2) { p = __builtin_amdgcn_mfma_f32_32x32x16_bf16(kc[d0], *(const LAS bf16x8*)(U.wl + WL_Q + U.lane * 16 + d0 * 1024), p, 0, 0, 0);
        p2 = __builtin_amdgcn_mfma_f32_32x32x16_bf16(kc[d0 + 1], *(const LAS bf16x8*)(U.wl + WL_Q + U.lane * 16 + (d0 + 1) * 1024), p2, 0, 0, 0); }
    if (has_next) {
        const bf16* kp = U.kp + (size_t)(pn >> 5) * 4096 + U.lane * 8;
#pragma unroll
        for (int d0 = 0; d0 < 8; ++d0) kc[d0] = *(const bf16x8*)(kp + 512 * d0);
    }
    float pmax;
    { float pm4[4] = {NEGV, NEGV, NEGV, NEGV};
#pragma unroll
      for (int rr = 0; rr < 16; ++rr) { p[rr] += p2[rr]; pm4[rr & 3] = fmaxf(pm4[rr & 3], p[rr]); }
      pmax = fmaxf(fmaxf(pm4[0], pm4[1]), fmaxf(pm4[2], pm4[3])); }
    pmax = half_max(pmax);
    const bool started = (m_run != NEGV), live = pmax > 0.5f * NEGV;
    float alpha = 1.f;
    if (__builtin_expect(__any(started ? (pmax > 8.0f * LOG2E) : live), 0)) {
        const float delta = started ? fmaxf(pmax, 0.f) : (live ? pmax : 0.f);
        alpha = started ? __builtin_amdgcn_exp2f(-delta) : (live ? 0.f : 1.f);
        m_run = started ? m_run + delta : (live ? delta : NEGV);
#pragma unroll
        for (int rr = 0; rr < 16; ++rr) p[rr] -= delta; }
    float psum;
    { float ps4[4] = {0.f, 0.f, 0.f, 0.f};
#pragma unroll
      for (int rr = 0; rr < 16; ++rr) { p[rr] = __builtin_amdgcn_exp2f(p[rr]); ps4[rr & 3] += p[rr]; }
      psum = (ps4[0] + ps4[1]) + (ps4[2] + ps4[3]); }
    psum = half_sum(psum); l_run = l_run * alpha + psum;
    LAS float* al_l = (LAS float*)(U.wl + WL_X);
    if (__any(alpha < 1.f)) {
        if (hi == 0) al_l[q] = alpha;
        LDS_WAIT();
#pragma unroll
        for (int rr = 0; rr < 16; ++rr) { const float a = al_l[crow(rr, hi)];
#pragma unroll
            for (int d = 0; d < 4; ++d) o[d][rr] *= a; }
    }
    bf16x8 pa0, pa1; PK4(p, 0, pa0); PK4(p, 8, pa1);
#pragma unroll
    for (int i = 0; i < 8; ++i) *(LAS bf16x8*)(U.wl + WL_V + v_st(vkey0 + 4 * i, vcol)) = vs[i];
    if (has_next) {
        unsigned voff = (unsigned)(((vkey0 << U.dsh) + U.r) * NQKV + vcol); asm volatile("" : "+v"(voff));
        const bf16* vrow = U.vp + (size_t)(pn << U.dsh) * NQKV;
#pragma unroll
        for (int i = 0; i < 8; ++i) vs[i] = *(const bf16x8*)(vrow + (size_t)((4 * i) << U.dsh) * NQKV + voff);
    }
    asm volatile("" ::: "memory");
    const int vb = lds_addr(U.wl + WL_V) + v_rd_base(U.lane);
#define PVR(D0, l0, h0, l1, h1) const s16x4 l0 = tr_read<v_rd_off(D0, 0, 0)>(vb), h0 = tr_read<v_rd_off(D0, 0, 1)>(vb), l1 = tr_read<v_rd_off(D0, 1, 0)>(vb), h1 = tr_read<v_rd_off(D0, 1, 1)>(vb)
#define PVM(D0, l0, h0, l1, h1) do { o[D0] = __builtin_amdgcn_mfma_f32_32x32x16_bf16(pa0, PKV(l0, h0), o[D0], 0, 0, 0); o[D0] = __builtin_amdgcn_mfma_f32_32x32x16_bf16(pa1, PKV(l1, h1), o[D0], 0, 0, 0); } while (0)
    PVR(0, a0l, a0h, a1l, a1h); PVR(1, b0l, b0h, b1l, b1h);
    asm volatile("s_waitcnt lgkmcnt(0)" ::: "memory"); SBAR();
    PVR(2, c0l, c0h, c1l, c1h); PVR(3, d0l, d0h, d1l, d1h);
    PVM(0, a0l, a0h, a1l, a1h); PVM(1, b0l, b0h, b1l, b1h);
    asm volatile("s_waitcnt lgkmcnt(0)" ::: "memory"); SBAR();
    PVM(2, c0l, c0h, c1l, c1h); PVM(3, d0l, d0h, d1l, d1h);
#undef PVR
#undef PVM
}
template <int MODE>
__device__ __forceinline__ void wu_run(const WUnit<MODE>& U, int ps_begin, bool desc  , bf16* __restrict__ Ob, int ldo, float* __restrict__ lse) {
    const int q = U.lane & 31, hi = U.lane >> 5, vkey0 = U.lane >> 4, vcol = (U.lane & 15) * 8;
    { const bf16* qp = U.qp + (size_t)(((U.p0 + q) << U.dsh) + U.r) * NQKV + 8 * hi;
#pragma unroll
      for (int d0 = 0; d0 < 8; ++d0) *(LAS bf16x8*)(U.wl + WL_Q + U.lane * 16 + d0 * 1024) = *(const bf16x8*)(qp + 16 * d0); }
    f32x16 o[4] = {}; float m_run = NEGV, l_run = 0.f;
    bf16x8 kc[8], vs[8]; unsigned mw = 0u;
    { unsigned voff = (unsigned)(((vkey0 << U.dsh) + U.r) * NQKV + vcol); asm volatile("" : "+v"(voff));
      const bf16* vrow = U.vp + (size_t)((desc ? U.p0 : ps_begin) << U.dsh) * NQKV;
#pragma unroll
      for (int i = 0; i < 8; ++i) vs[i] = *(const bf16x8*)(vrow + (size_t)((4 * i) << U.dsh) * NQKV + voff); }
    const int ps0 = desc ? U.p0 : ps_begin, step = desc ? -32 : 32, nblk = ((U.p0 - ps_begin) >> 5) + 1;
    { const bf16* kp = U.kp + (size_t)(ps0 >> 5) * 4096 + U.lane * 8;
#pragma unroll
      for (int d0 = 0; d0 < 8; ++d0) kc[d0] = *(const bf16x8*)(kp + 512 * d0);
      if (MODE == 1) mw = U.mrow[ps0 >> 5]; }
#pragma unroll 1
    for (int k = 0, ps = ps0; k < nblk; ++k, ps += step) wu_block<MODE>(U, kc, vs, mw, k + 1 < nblk, ps, ps + step, o, m_run, l_run);
    LAS float* li_l = (LAS float*)(U.wl + WL_X) + 32;
    if (hi == 0) li_l[q] = l_run;
    LDS_WAIT();
    if (MODE == 0) {
#pragma unroll
        for (int rr = 0; rr < 16; ++rr) { const float rl = __builtin_amdgcn_rcpf(li_l[crow(rr, hi)]); LAS bf16* rowp = (LAS bf16*)(U.wl + WL_V + crow(rr, hi) * 256) + q;
#pragma unroll
            for (int d = 0; d < 4; ++d) rowp[32 * d] = (bf16)f2bf(o[d][rr] * rl); }
        LDS_WAIT();
        unsigned ooff = (unsigned)(((vkey0 << U.dsh) + U.r) * ldo + vcol); asm volatile("" : "+v"(ooff));
        bf16* orow = Ob + (size_t)(U.p0 << U.dsh) * ldo;
#pragma unroll
        for (int i = 0; i < 8; ++i) { const bf16x8 v = *(const LAS bf16x8*)(U.wl + WL_V + (vkey0 + 4 * i) * 256 + vcol * 2);
            *(bf16x8*)(orow + (size_t)((4 * i) << U.dsh) * ldo + ooff) = v; }
    } else {
#pragma unroll
        for (int rr = 0; rr < 16; ++rr) { const float rl = __builtin_amdgcn_rcpf(li_l[crow(rr, hi)]) * O8_SCALE; LAS unsigned char* rowp = U.wl + WL_V + crow(rr, hi) * 128 + q;
#pragma unroll
            for (int d = 0; d < 4; ++d) { const float x = o[d][rr] * rl; rowp[32 * d] = (unsigned char)__builtin_amdgcn_cvt_pk_fp8_f32(x, x, 0, false); } }
        LDS_WAIT();
        unsigned ooff = (unsigned)((U.lane >> 3) * ldo + (U.lane & 7) * 16); asm volatile("" : "+v"(ooff));
        unsigned char* orow = (unsigned char*)Ob + (size_t)U.p0 * ldo;
#pragma unroll
        for (int i = 0; i < 4; ++i) { const v4u v = *(const LAS v4u*)(U.wl + WL_V + ((U.lane >> 3) + 8 * i) * 128 + (U.lane & 7) * 16);
            *(v4u*)(orow + (size_t)(8 * i) * ldo + ooff) = v; }
    }
    if (MODE == 0) { if (hi == 0) lse[(size_t)(((U.p0 + q) << U.dsh) + U.r) * 4] = m_run + __builtin_amdgcn_logf(l_run); }
    LDS_WAIT();
}

namespace ab {
constexpr int D = 128, KVBLK = 64, LDQ = NQKV, LDK = NQKV, LDO = KP;
constexpr int SHM_V = KVBLK * D * 2, SHM_K = KVBLK * D * 2, SHM_ATTN = 2 * SHM_V + 2 * SHM_K + NWAVES * 64 * 4;
constexpr int GUARD = 260, TABD_N = GUARD + 2048, TABB_OFF = SHM_ATTN;
constexpr int QS_OFF = 77824, QS_WAVE = 8192;
constexpr float THR2 = 8.0f * LOG2E;
#ifndef AB_SDEPTH
#define AB_SDEPTH 1
#endif
constexpr int SDEPTH = AB_SDEPTH;
__device__ __forceinline__ void initSM(f32x16& p0, f32x16& p1, float m_reg, const LAS float* tp) {
    const float mref = (m_reg == NEGV) ? 0.f : m_reg;
#pragma unroll
    for (int r = 0; r < 16; ++r) { const int cr = (r & 3) + 8 * (r >> 2); p0[r] = tp[cr] - mref; }
    SBAR();
#pragma unroll
    for (int r = 0; r < 16; ++r) { const int cr = (r & 3) + 8 * (r >> 2); p1[r] = tp[32 + cr] - mref; }
}
__device__ __forceinline__ float msel(unsigned m, int bit, float x) {
    const unsigned k = (unsigned)__builtin_amdgcn_sbfe((int)m, (unsigned)bit, 1u); return __uint_as_float(__builtin_amdgcn_bitop3_b32(k, __float_as_uint(x), __float_as_uint(NEGV), 0xCA));
}
__device__ __forceinline__ void partialSM(f32x16& p0, f32x16& p1, float& m_reg, float& alpha, unsigned mlo, unsigned mhi) {
#pragma unroll
    for (int r = 0; r < 16; ++r) { const int cr = (r & 3) + 8 * (r >> 2); p0[r] = msel(mlo, cr, p0[r]); p1[r] = msel(mhi, cr, p1[r]); }
    float pmax;
    { float pm4[4] = {p0[0], p0[1], p0[2], p0[3]};
#pragma unroll
      for (int r = 4; r < 16; ++r) pm4[r & 3] = fmaxf(pm4[r & 3], p0[r]);
#pragma unroll
      for (int r = 0; r < 16; ++r) pm4[r & 3] = fmaxf(pm4[r & 3], p1[r]);
      pmax = fmaxf(fmaxf(pm4[0], pm4[1]), fmaxf(pm4[2], pm4[3])); }
    pmax = half_max(pmax);
    const bool started = (m_reg != NEGV), live = pmax > 0.5f * NEGV;
    if (__builtin_expect(!__any(started ? (pmax > THR2) : live), 1)) { alpha = 1.f; }
    else { const float delta = started ? fmaxf(pmax, 0.f) : (live ? pmax : 0.f);
        alpha = started ? __builtin_amdgcn_exp2f(-delta) : (live ? 0.f : 1.f);
        m_reg = started ? m_reg + delta : (live ? delta : NEGV);
#pragma unroll
        for (int r = 0; r < 16; ++r) { p0[r] -= delta; p1[r] -= delta; } }
#pragma unroll
    for (int r = 0; r < 16; ++r) p0[r] = __builtin_amdgcn_exp2f(p0[r]);
}
__device__ __forceinline__ void finishSM(f32x16& p0, f32x16& p1, float alpha, float& l_reg, bf16x8& pa0, bf16x8& pa1, bf16x8& pa2, bf16x8& pa3) {
#pragma unroll
    for (int r = 0; r < 16; ++r) p1[r] = __builtin_amdgcn_exp2f(p1[r]);
    float ps;
    { float ps4[4] = {0.f, 0.f, 0.f, 0.f};
#pragma unroll
      for (int r = 0; r < 16; ++r) ps4[r & 3] += p0[r];
#pragma unroll
      for (int r = 0; r < 16; ++r) ps4[r & 3] += p1[r];
      ps = (ps4[0] + ps4[1]) + (ps4[2] + ps4[3]); }
    ps = half_sum(ps);
    l_reg = l_reg * alpha + ps;
    PK4(p0, 0, pa0); PK4(p0, 8, pa1); PK4(p1, 0, pa2); PK4(p1, 8, pa3);
}
#ifndef AB_QREG
#define AB_QREG 1
#endif
__device__ __forceinline__ void qkt_r(f32x16& p0, f32x16& p1, const LAS unsigned char* Ks, const bf16x8 (&qf)[8], int r32, int hi) {
#pragma unroll
    for (int d0 = 0; d0 < 8; ++d0) { const int lo_ = (r32 + 32 * hi) * 16;
        const bf16x8 b0 = *(const LAS bf16x8*)(Ks + d0 * 1024 + lo_);
        const bf16x8 b1 = *(const LAS bf16x8*)(Ks + 8192 + d0 * 1024 + lo_);
        p0 = __builtin_amdgcn_mfma_f32_32x32x16_bf16(b0, qf[d0], p0, 0, 0, 0);
        p1 = __builtin_amdgcn_mfma_f32_32x32x16_bf16(b1, qf[d0], p1, 0, 0, 0); }
}
__device__ __forceinline__ void qkt(f32x16& p0, f32x16& p1, const LAS unsigned char* Ks, const LAS unsigned char* qs, int r32, int hi) {
#pragma unroll
    for (int d0 = 0; d0 < 8; ++d0) { const int lo_ = (r32 + 32 * hi) * 16;
        const bf16x8 b0 = *(const LAS bf16x8*)(Ks + d0 * 1024 + lo_);
        const bf16x8 b1 = *(const LAS bf16x8*)(Ks + 8192 + d0 * 1024 + lo_);
        const bf16x8 q = *(const LAS bf16x8*)(qs + d0 * 1024);
        p0 = __builtin_amdgcn_mfma_f32_32x32x16_bf16(b0, q, p0, 0, 0, 0);
        p1 = __builtin_amdgcn_mfma_f32_32x32x16_bf16(b1, q, p1, 0, 0, 0); }
}
template <int D0> __device__ __forceinline__ void pv_one(f32x16& od, int vb, bf16x8 pa0, bf16x8 pa1, bf16x8 pa2, bf16x8 pa3) {
    const s16x4 l0 = tr_read<v_rd_off(D0, 0, 0)>(vb), h0 = tr_read<v_rd_off(D0, 0, 1)>(vb), l1 = tr_read<v_rd_off(D0, 1, 0)>(vb), h1 = tr_read<v_rd_off(D0, 1, 1)>(vb);
    const s16x4 l2 = tr_read<v_rd_off(D0, 2, 0)>(vb), h2 = tr_read<v_rd_off(D0, 2, 1)>(vb), l3 = tr_read<v_rd_off(D0, 3, 0)>(vb), h3 = tr_read<v_rd_off(D0, 3, 1)>(vb);
    asm volatile("s_waitcnt lgkmcnt(0)" ::: "memory"); SBAR();
    od = __builtin_amdgcn_mfma_f32_32x32x16_bf16(pa0, PKV(l0, h0), od, 0, 0, 0);
    od = __builtin_amdgcn_mfma_f32_32x32x16_bf16(pa1, PKV(l1, h1), od, 0, 0, 0);
    od = __builtin_amdgcn_mfma_f32_32x32x16_bf16(pa2, PKV(l2, h2), od, 0, 0, 0);
    od = __builtin_amdgcn_mfma_f32_32x32x16_bf16(pa3, PKV(l3, h3), od, 0, 0, 0);
}
__device__ __forceinline__ void pv_d0(f32x16* o, int vb, bf16x8 pa0, bf16x8 pa1, bf16x8 pa2, bf16x8 pa3) {
    pv_one<0>(o[0], vb, pa0, pa1, pa2, pa3); pv_one<1>(o[1], vb, pa0, pa1, pa2, pa3); pv_one<2>(o[2], vb, pa0, pa1, pa2, pa3); pv_one<3>(o[3], vb, pa0, pa1, pa2, pa3);
}
__device__ __forceinline__ void attnB_block(const bf16* __restrict__ Qb, const bf16* __restrict__ Kh, const bf16* __restrict__ Vh, unsigned char* __restrict__ Ob,
                                            const unsigned* __restrict__ mrow0, int tq0, int NT, LAS unsigned char* lds) {
    const int tid = threadIdx.x, wid = tid >> 6, lane = tid & 63, r32 = lane & 31, hi = lane >> 5;
    LAS unsigned char* V_lds = lds; LAS unsigned char* K_lds = lds + 2 * SHM_V;
    LAS float* ws = (LAS float*)(lds + 2 * SHM_V + 2 * SHM_K) + wid * 64; LAS float* li_l = ws; LAS float* al_l = ws + 32;
    float m_reg = NEGV, l_reg = 0; f32x16 o[4] = {};
    bf16x8 qf[8];
    LAS unsigned char* qr = lds + QS_OFF + wid * QS_WAVE + lane * 16;
    { unsigned qoff = (unsigned)((wid * 32 + r32) * LDQ + hi * 8) * 2u; asm volatile("" : "+v"(qoff));
#pragma unroll
      for (int d0 = 0; d0 < 8; ++d0) { qf[d0] = *(const bf16x8*)((const char*)Qb + qoff + d0 * 32); if (!AB_QREG) *(LAS bf16x8*)(qr + d0 * 1024) = qf[d0]; } }
    const int sr = tid >> 4, sc = (tid & 15) * 8, vst0 = v_st(sr, sc), vst1 = vst0 + 8192;
    const int vb0 = lds_addr(V_lds) + v_rd_base(lane);
    unsigned voffV = (unsigned)(sr * LDK + sc) * 2u, voffK = (unsigned)tid * 16u, voffM = (unsigned)(wid * 32 + r32) * 256u; asm volatile("" : "+v"(voffV), "+v"(voffK), "+v"(voffM));
    const LAS float* tp0 = (const LAS float*)(lds + TABB_OFF) + (TABD_N - 1 - GUARD - (tq0 + wid * 32 + r32) + 4 * hi);
    struct { bf16x8 vs0, vs1, ks0, ks1; unsigned long long mk; } sr_[SDEPTH];
#define SLOAD(i, k0) do { const char* vb_ = (const char*)Vh + (size_t)(k0) * (LDK * 2); const char* kb_ = (const char*)Kh + (size_t)(k0) * 256; \
    sr_[i].vs0 = *(const bf16x8*)(vb_ + voffV); sr_[i].vs1 = *(const bf16x8*)(vb_ + 32 * LDK * 2 + voffV); \
    sr_[i].ks0 = *(const bf16x8*)(kb_ + voffK); sr_[i].ks1 = *(const bf16x8*)(kb_ + 8192 + voffK); sr_[i].mk = *(const unsigned long long*)((const char*)mrow0 + (size_t)((k0) >> 6) * 8 + voffM); } while (0)
#define SWRITE(b, i) do { *(LAS bf16x8*)(V_lds + (b) * SHM_V + vst0) = sr_[i].vs0; *(LAS bf16x8*)(V_lds + (b) * SHM_V + vst1) = sr_[i].vs1; const int kc = sc * 2;  \
    *(LAS bf16x8*)(K_lds + (b) * SHM_K + voffK) = sr_[i].ks0; *(LAS bf16x8*)(K_lds + (b) * SHM_K + 8192 + voffK) = sr_[i].ks1; (void)kc; } while (0)
#define SWAIT() do { if constexpr (SDEPTH == 2) asm volatile("s_waitcnt vmcnt(5)" ::: "memory"); else asm volatile("s_waitcnt vmcnt(0)" ::: "memory"); } while (0)
#define RESC(a) do { if (__any((a) < 1.f)) { if (hi == 0) al_l[r32] = (a); asm volatile("s_waitcnt lgkmcnt(0)" ::: "memory"); \
    _Pragma("unroll") for (int d = 0; d < 4; ++d) _Pragma("unroll") for (int r = 0; r < 16; ++r) o[d][r] *= al_l[crow(r, hi)]; } } while (0)
#define QKT(P0, P1, KS) do { if (AB_QREG) qkt_r(P0, P1, KS, qf, r32, hi); else qkt(P0, P1, KS, qr, r32, hi); } while (0)
#define MLO(m) ((unsigned)(m) >> (4 * hi))
#define MHI(m) ((unsigned)((m) >> 32) >> (4 * hi))
    f32x16 pA0, pA1, pB0, pB1; float alA, alB; bf16x8 pa0, pa1, pa2, pa3; unsigned long long mA, mB;
    constexpr int SE = 0, SO = SDEPTH - 1;
    if (__builtin_amdgcn_readfirstlane(threadIdx.x) >= 256) __builtin_amdgcn_s_setprio(1);
    SLOAD(SE, 0); asm volatile("s_waitcnt vmcnt(0)" ::: "memory"); SWRITE(0, SE); mA = sr_[SE].mk; __syncthreads();
    initSM(pA0, pA1, m_reg, tp0); QKT(pA0, pA1, K_lds); partialSM(pA0, pA1, m_reg, alA, MLO(mA), MHI(mA));
    SLOAD(SO, KVBLK); if constexpr (SDEPTH == 2) { if (2 < NT) SLOAD(SE, 2 * KVBLK); }
    SWAIT(); SWRITE(1, SO); mB = sr_[SO].mk; __syncthreads();
    for (int j = 1; j + 1 < NT; j += 2) {
        SBAR(); initSM(pB0, pB1, m_reg, tp0 + j * KVBLK); QKT(pB0, pB1, K_lds + SHM_K);
        finishSM(pA0, pA1, alA, l_reg, pa0, pa1, pa2, pa3); SBAR();
        SLOAD(SO, (j + SDEPTH) * KVBLK); SBAR();
        pv_d0(o, vb0, pa0, pa1, pa2, pa3); partialSM(pB0, pB1, m_reg, alB, MLO(mB), MHI(mB));
        __syncthreads(); SWAIT(); SWRITE(0, SE); mA = sr_[SE].mk;
        RESC(alB); __syncthreads();
        SBAR(); initSM(pA0, pA1, m_reg, tp0 + (j + 1) * KVBLK); QKT(pA0, pA1, K_lds);
        finishSM(pB0, pB1, alB, l_reg, pa0, pa1, pa2, pa3); SBAR();
        if (SDEPTH == 1 || j + 3 < NT) SLOAD(SE, (j + 1 + SDEPTH) * KVBLK); SBAR();
        pv_d0(o, vb0 + SHM_V, pa0, pa1, pa2, pa3); partialSM(pA0, pA1, m_reg, alA, MLO(mA), MHI(mA));
        __syncthreads(); SWAIT(); SWRITE(1, SO); mB = sr_[SO].mk;
        RESC(alA); __syncthreads();
    }
    SBAR(); initSM(pB0, pB1, m_reg, tp0 + (NT - 1) * KVBLK); QKT(pB0, pB1, K_lds + SHM_K);
    finishSM(pA0, pA1, alA, l_reg, pa0, pa1, pa2, pa3); SBAR();
    pv_d0(o, vb0, pa0, pa1, pa2, pa3); partialSM(pB0, pB1, m_reg, alB, MLO(mB), MHI(mB));
    __syncthreads(); RESC(alB);
    finishSM(pB0, pB1, alB, l_reg, pa0, pa1, pa2, pa3); SBAR();
    pv_d0(o, vb0 + SHM_V, pa0, pa1, pa2, pa3);
    __builtin_amdgcn_s_setprio(0);
    if (hi == 0) li_l[r32] = l_reg; asm volatile("s_waitcnt lgkmcnt(0)" ::: "memory");
    LAS unsigned char* st = lds + QS_OFF + wid * QS_WAVE;
    int le = lane; asm volatile("" : "+v"(le)); const int r32e = le & 31, hie = le >> 5;
#pragma unroll
    for (int r = 0; r < 16; ++r) { const float rl = __builtin_amdgcn_rcpf(li_l[crow(r, hie)]) * O8_SCALE; LAS unsigned char* rowp = st + crow(r, hie) * 128 + r32e;
#pragma unroll
        for (int d0 = 0; d0 < 4; ++d0) { const float x = o[d0][r] * rl; rowp[32 * d0] = (unsigned char)__builtin_amdgcn_cvt_pk_fp8_f32(x, x, 0, false); } }
    asm volatile("s_waitcnt lgkmcnt(0)" ::: "memory");
    unsigned char* Ow = Ob + (long)(wid * 32) * LDO;
#pragma unroll
    for (int i = 0; i < 4; ++i) { const int row = (le >> 3) + 8 * i; const v4u v = *(const LAS v4u*)(st + row * 128 + (le & 7) * 16); *(v4u*)(Ow + (long)row * LDO + (le & 7) * 16) = v; }
    asm volatile("s_waitcnt lgkmcnt(0)" ::: "memory");
#undef SLOAD
#undef SWRITE
#undef SWAIT
#undef RESC
#undef MLO
#undef QKT
#undef MHI
}
}
struct Args { const float* in[13]; float* out; unsigned char* ws; int ph_lo, ph_hi, grid, pad; };
__global__ void __launch_bounds__(NWAVES * 64, 2) fwd(Args args) {
    extern __shared__ __attribute__((aligned(16))) unsigned char lds_raw[];
    Frame F;
    F.lds = (LAS unsigned char*)lds_raw;
    F.MISC = (volatile LAS unsigned*)(F.lds + MISC_OFF);
    F.tid = threadIdx.x; F.lane = F.tid & 63; F.wave = __builtin_amdgcn_readfirstlane(F.tid >> 6);
#define KA(A_) const __attribute__((address_space(4))) Args* A_ = (const __attribute__((address_space(4))) Args*)__builtin_amdgcn_kernarg_segment_ptr(); asm volatile("" : "+s"(A_))
    int lo, hi;
#define FRAME() do { KA(Af_); F.ctl = (gu32*)(Af_->ws + WS_CTL); lo = Af_->ph_lo; hi = Af_->ph_hi; F.lds = (LAS unsigned char*)lds_raw; F.MISC = (volatile LAS unsigned*)(F.lds + MISC_OFF); \
        F.tid = threadIdx.x; asm volatile("" : "+v"(F.tid)); F.lane = F.tid & 63; F.wave = __builtin_amdgcn_readfirstlane(F.tid >> 6); F.G = Af_->grid; { const int bx = blockIdx.x; F.vcu = (F.G % 8 == 0) ? (bx % 8) * (F.G / 8) + bx / 8 : bx; } } while (0)
    FRAME();
    for (int u = F.tid; u < (LDS_BYTES - LDSCTL_OFF) / 4; u += NWAVES * 64) ((LAS unsigned*)(F.lds + LDSCTL_OFF))[u] = 0u;
    __syncthreads();
    if (hi - lo > 1) (void)xcd_barrier_post((unsigned*)(F.ctl + CW_BAR), F.MISC + 8);
#define SEAM(k) do { FRAME(); if (IN(k) && IN((k) + 1)) { XcdBarrier bar_; bar_.bar = (unsigned*)(F.ctl + CW_BAR); bar_.x = xb_xcc_id(); bar_.G = (unsigned)F.G; bar_.st = F.MISC + 8; xcd_barrier(bar_); } } while (0)
#ifdef PH_ONLY
#define IN(k) ((k) == PH_ONLY && lo <= (k) && (k) < hi)
#else
#define IN(k) (lo <= (k) && (k) < hi)
#endif

#define P0ARGS(A_, Ap_, ws_) P0Args A_{Ap_->in[0], Ap_->in[1], Ap_->in[2], Ap_->in[6], Ap_->in[7], Ap_->in[8], Ap_->in[9], Ap_->in[10], Ap_->in[11], ws_ + WS_W1Q8, ws_ + WS_W1G8, (bf16*)(ws_ + WS_W1I), ws_ + WS_WP8, ws_ + WS_WO8, \
        (bf16*)(ws_ + WS_WU), (bf16*)(ws_ + WS_WD), (bf16*)(ws_ + WS_XB), ws_ + WS_X8, (float*)(ws_ + CTL_RSTD0)}
#define P0_DEFERRED_SLOT(slot_) do { if (((((int)blockIdx.x & 7) * 3) >> 3) == (slot_)) { __syncthreads(); { KA(Ad_); unsigned char* wsd_ = Ad_->ws; P0ARGS(Ad, Ad_, wsd_); FRAME(); p0_prologue<true>(F, Ad); } __syncthreads(); } } while (0)
    FRAME();
    if (IN(0)) {
        KA(Ap); unsigned char* ws = Ap->ws;
        { P0ARGS(A, Ap, ws); p0_prologue<false>(F, A); }
        SEAM(0);
    }
    FRAME();
    if (IN(1)) {
        P0_DEFERRED_SLOT(0);
        KA(Ap); unsigned char* ws = Ap->ws;
        const bool bal = (F.G == 256);
        { pg8::Gemm g{(bf16*)(ws + WS_X8), (bf16*)(ws + WS_W1Q8), M, NQKV_W, DM / 2};
          pg8::BalancedOrder S; if (bal) S.init(M, NQKV_W, F.G, (int)blockIdx.x, 6, 192, 2, true); else S.init(M, NQKV_W, F.G, (int)blockIdx.x, 1 << 20, 0, 0, true);
          pg8::EpiQKV E{1.0f / W8_SCALE, (bf16*)(ws + WS_QKV), (bf16*)(ws + WS_KAF), (size_t)(WS_KBF - WS_KAF) / 2, (const float*)(ws + CTL_RSTD0)};
          pg8::gemm_phase<pg8::EpiQKV, pg8::BalancedOrder, true, true, true>(F.lds, g, S, E); }
        __syncthreads();
        P0_DEFERRED_SLOT(1);
        { pg8::Gemm g{(bf16*)(ws + WS_XB), (bf16*)(ws + WS_W1I), M, N1I, DM};
          pg8::BalancedOrder S; if (bal) S.init(M, N1I, F.G, (int)blockIdx.x, 1, 192, 1, false); else S.init(M, N1I, F.G, (int)blockIdx.x, 1 << 20, 0, 0, true);
          typedef pg8::EpiIdx<WS_QI, WS_KI, WS_WI, CTL_RSTD0> EpiIdxT; EpiIdxT E{ws, Ap->in[3], Ap->in[4]};
          pg8::gemm_phase<EpiIdxT, pg8::BalancedOrder, true, true, false>(F.lds, g, S, E); }
        P0_DEFERRED_SLOT(2);
        SEAM(1);
    }
    FRAME();
    if (IN(2)) { }
    FRAME();
    if (IN(3)) {
        KA(Ap); unsigned char* ws = Ap->ws; unsigned char* dob = (unsigned char*)Ap->out;
        const bf16* QKV = (const bf16*)(ws + WS_QKV); const bf16* KAF = (const bf16*)(ws + WS_KAF); const bf16* QI = (const bf16*)(ws + WS_QI); const bf16* KI = (const bf16*)(ws + WS_KI); const float* WI = (const float*)(ws + WS_WI); unsigned* MASK = (unsigned*)(ws + WS_MASK);
        bf16* OAP = (bf16*)(dob + DO_OAP); float* LSE = (float*)(dob + DO_LSE);
        const float* tbl = Ap->in[5];
        LAS float* tabA = (LAS float*)(F.lds + NWAVES * WL_BYTES);
        for (int i = F.tid; i < 12 * TABA_N; i += NWAVES * 64) { const int gh = i / TABA_N, j = i % TABA_N - 32, g = gh >> 2;
            tabA[gh * TABA_N + (TABA_N - 1 - i % TABA_N)] = (j >= 0 && j <= 128) ? tbl[t5_bucket(j << (2 * g)) * 20 + gh] * LOG2E : NEGV; }
        __syncthreads();
        const int gw = F.vcu * NWAVES + F.wave, NGW = F.G * NWAVES;
#pragma unroll 1
        for (int st = 0; st < 2; ++st) { const bool do_idx = (st == 0) != (F.wave >= 4);
        if (do_idx) {
        for (int i = gw, j = 0; i < BATCH * (SEQ / 2); i += NGW, ++j) { const int b = i / (SEQ / 2), pi = i % (SEQ / 2); const int pr = (j & 1) ? (SEQ / 2 - 1 - pi) : pi;
            index_unit(QI, KI, WI, MASK, b, 2 * pr, F.lane); }
        } else {
        for (int i = gw; i < BATCH * 3 * 4 * 64; i += NGW) { const int u = i & 63, h = (i >> 6) & 3, g = (i >> 8) % 3, b = (i >> 8) / 3;
            const int nblk = (SEQ >> (2 * g)) / 32;
            const size_t tb = (size_t)b * SEQ; const int col = g * 512 + h * 128, p0 = (u % nblk) * 32, r = u / nblk;
            WUnit<0> U{QKV + tb * NQKV + col, KAF + ((size_t)(((b * 3 + g) * 4 + h) * 64 + r * nblk)) * 4096, QKV + tb * NQKV + 1536 + col, 2 * g, r, p0, tabA + (g * 4 + h) * TABA_N, nullptr, F.lds + F.wave * WL_BYTES, F.lane};
            wu_run<0>(U, p0 >= 128 ? p0 - 128 : 0, false, OAP + ((size_t)g * M + tb) * 512 + h * 128, 512, LSE + ((size_t)g * M + tb) * 4 + h); }
        } }
        VM_WAIT(); __syncthreads();
        SEAM(3);
    }
    FRAME();
    if (IN(4)) {
        KA(Ap); unsigned char* ws = Ap->ws; unsigned char* dob = (unsigned char*)Ap->out;
        const bf16* QKV = (const bf16*)(ws + WS_QKV); const bf16* KBF = (const bf16*)(ws + WS_KBF); const unsigned* MASK = (const unsigned*)(ws + WS_MASK);
        const bf16* OAP = (const bf16*)(dob + DO_OAP); const float* LSE = (const float*)(dob + DO_LSE); unsigned char* OAB = dob + DO_OAB;
        for (int pc = (int)blockIdx.x * (NWAVES * 64) + F.tid; pc < M * 64; pc += F.G * NWAVES * 64) { const int tok = pc >> 6, hh = (pc >> 4) & 3, c = (pc & 15) * 8;
            const float l0 = LSE[(size_t)tok * 4 + hh], l1 = LSE[((size_t)M + tok) * 4 + hh], l2 = LSE[((size_t)2 * M + tok) * 4 + hh];
            const float mx = fmaxf(l0, fmaxf(l1, l2)); float w0 = __builtin_amdgcn_exp2f(l0 - mx), w1 = __builtin_amdgcn_exp2f(l1 - mx), w2 = __builtin_amdgcn_exp2f(l2 - mx);
            const float inv = 1.0f / (w0 + w1 + w2); w0 *= inv; w1 *= inv; w2 *= inv;
            const size_t off = (size_t)tok * 512 + hh * 128 + c;
            const v4u a = *(const v4u*)(OAP + off), bq = *(const v4u*)(OAP + (size_t)M * 512 + off), cq = *(const v4u*)(OAP + (size_t)2 * M * 512 + off);
            f32x4 a0, a1, b0, b1, c0, c1; pg8::unpack8(a, a0, a1); pg8::unpack8(bq, b0, b1); pg8::unpack8(cq, c0, c1);
            const f32x4 r0 = (a0 * w0 + b0 * w1 + c0 * w2) * O8_SCALE, r1 = (a1 * w0 + b1 * w1 + c1 * w2) * O8_SCALE; typedef unsigned u32x2 __attribute__((ext_vector_type(2)));
            *(u32x2*)(OAB + (size_t)tok * KP + hh * 128 + c) = (u32x2){pk4_fp8(r0[0], r0[1], r0[2], r0[3]), pk4_fp8(r1[0], r1[1], r1[2], r1[3])}; }
        const float* tbl = Ap->in[5];
        LAS float* tabB = (LAS float*)(F.lds + ab::TABB_OFF);
        for (int u = F.vcu; u < BATCH * 8 * 4; u += F.G) { const int b = u >> 5, h = (u >> 2) & 7, xq = u & 3;
            __syncthreads();
            int ti_ = F.tid; asm volatile("" : "+v"(ti_));
            for (int i = ti_; i < ab::TABD_N; i += NWAVES * 64) { const int dist = i - ab::GUARD; tabB[ab::TABD_N - 1 - i] = dist >= 0 ? tbl[t5_bucket(dist) * 20 + 12 + h] * LOG2E : 0.f; }
            __syncthreads();
            const size_t tb = (size_t)b * SEQ;
#pragma unroll 1
            for (int half = 0; half < 2; ++half) { const int qb = half ? xq : 7 - xq; const size_t row0 = tb + (size_t)qb * 256;
                ab::attnB_block(QKV + row0 * NQKV + 3072 + h * 128, KBF + (size_t)((b * 8 + h) * 64) * 4096, QKV + tb * NQKV + 4096 + h * 128, OAB + row0 * KP + 512 + h * 128,
                                MASK + row0 * 64, qb * 256, 4 * (qb + 1), F.lds);
                __syncthreads(); }
        }
        VM_WAIT(); __syncthreads();
    }
    FRAME();
    if (IN(5)) {
        KA(Ap); unsigned char* ws = Ap->ws; bf16* Rlo = (bf16*)(ws + WS_R_LO); bf16* SBlo = (bf16*)(ws + WS_SB_LO);
        const long r_hi = ((long)WS_R_HI - (long)WS_R_LO) / 2 - (long)(M / 2) * DM, sb_hi = ((long)((uintptr_t)Ap->out + DO_SB_HI) - (long)(uintptr_t)(ws + WS_SB_LO)) / 2 - (long)(M / 2) * DM;
        pg8::Gemm g{(bf16*)(ws + WS_X8), (bf16*)(ws + WS_W1G8), M, NG, DM / 2}; pg8::DenseOrder<16> S; S.init(0, M / 256, F.G, (int)blockIdx.x, 1);
        pg8::EpiGate E{Rlo, SBlo, r_hi, sb_hi, (const float*)(ws + CTL_RSTD0), 1.0f / W8_SCALE};
        pg8::gemm_phase<pg8::EpiGate, pg8::DenseOrder<16>, true, true, true>(F.lds, g, S, E);
        SEAM(5);
    }
    FRAME();
    if (IN(6)) {
        KA(Ap); unsigned char* ws = Ap->ws; bf16* Rlo = (bf16*)(ws + WS_R_LO); bf16* SBlo = (bf16*)(ws + WS_SB_LO);
        const long r_hi = ((long)WS_R_HI - (long)WS_R_LO) / 2 - (long)(M / 2) * DM, sb_hi = ((long)((uintptr_t)Ap->out + DO_SB_HI) - (long)(uintptr_t)(ws + WS_SB_LO)) / 2 - (long)(M / 2) * DM;
        pg8::Gemm g{(bf16*)((unsigned char*)Ap->out + DO_OAB), (bf16*)(ws + WS_WP8), M, DM, KP / 2}; pg8::DenseOrder<8> S; S.init(0, M / 256, F.G, (int)blockIdx.x, 0);
        pg8::EpiMerged<4> E{ws + WS_MG8, Rlo, SBlo, r_hi, sb_hi, O8_SCALE / (O8_SCALE * WP8_SCALE)};
        pg8::gemm_phase<pg8::EpiMerged<4>, pg8::DenseOrder<8>, true, true, true>(F.lds, g, S, E);
        SEAM(6);
    }
    FRAME();
    if (IN(7)) {
        KA(Ap); unsigned char* ws = Ap->ws;
        pg8::Gemm g{(bf16*)(ws + WS_MG8), (bf16*)(ws + WS_WO8), M, DM, DM / 2}; pg8::DenseOrder<8> S; S.init(0, M / 256, F.G, (int)blockIdx.x, 1);
        pg8::EpiResid E{(bf16*)(ws + WS_XB), (float*)(ws + CTL_SS1), 1.0f / (O8_SCALE * W8_SCALE)};
        pg8::gemm_phase<pg8::EpiResid, pg8::DenseOrder<8>, true, true, true>(F.lds, g, S, E);
        SEAM(7);
    }
    FRAME();
    if (IN(8)) {
        KA(Ap); unsigned char* ws = Ap->ws;
        pg8::Gemm g{(bf16*)(ws + WS_XB), (bf16*)(ws + WS_WU), M, DFF, DM}; pg8::WeightStationaryOrder S; S.init(F.G, (int)blockIdx.x, 1);
        pg8::EpiUp E{(bf16*)(ws + WS_H), (const float*)(ws + CTL_SS1)};
        pg8::gemm_phase<pg8::EpiUp, pg8::WeightStationaryOrder, true, true>(F.lds, g, S, E);
        SEAM(8);
    }
    FRAME();
    if (IN(9)) {
        KA(Ap); unsigned char* ws = Ap->ws;
        pg8::Gemm g{(bf16*)(ws + WS_H), (bf16*)(ws + WS_WD), M, DM, DFF}; pg8::DenseOrder<8> S; S.init(0, M / 256, F.G, (int)blockIdx.x, 0);
        pg8::EpiResid E{(bf16*)(ws + WS_XB), (float*)(ws + CTL_SS2), 1.0f};
        pg8::gemm_phase<pg8::EpiResid, pg8::DenseOrder<8>, true, true, false, true>(F.lds, g, S, E);
        SEAM(9);
    }
    FRAME();
    if (IN(10)) {
        KA(Ap); const float* gf = Ap->in[12]; float* outp = Ap->out; const float* ss2 = (const float*)(Ap->ws + CTL_SS2); const bf16* x2b = (const bf16*)(Ap->ws + WS_XB);
        const int gw = F.vcu * NWAVES + F.wave, NGW = F.G * NWAVES;
        f32x4 gv[8];
#pragma unroll
        for (int q = 0; q < 4; ++q) { gv[2 * q] = *((const f32x4*)(gf + 512 * q + 8 * F.lane)); gv[2 * q + 1] = *((const f32x4*)(gf + 512 * q + 8 * F.lane + 4)); }
        for (int m = gw; m < M; m += NGW) { const float rs = 1.0f / sqrtf(ss2[m] * (1.0f / DM) + 1e-6f);
            const GAS v4u* xr = (const GAS v4u*)(x2b + (size_t)m * DM) + F.lane; GAS f32x4* orow = (GAS f32x4*)(outp + (size_t)m * DM) + 2 * F.lane;
            v4u w[4];
#pragma unroll
            for (int q = 0; q < 4; ++q) w[q] = xr[64 * q];
#pragma unroll
            for (int q = 0; q < 4; ++q) { f32x4 a, b; pg8::unpack8(w[q], a, b); orow[128 * q] = a * rs * gv[2 * q]; orow[128 * q + 1] = b * rs * gv[2 * q + 1]; } }
    }
#undef IN
#undef SEAM
}

#ifndef MK_N_LAUNCHES
#define MK_N_LAUNCHES 1
#endif
extern "C" void kernel_launch(void* const* d_in, const int* in_sizes, int n_in, void* d_out, int out_size, void* d_ws, size_t ws_size, hipStream_t stream) {
    static int grid = 0;
    if (grid == 0) {
        if (n_in != 13 || in_sizes[0] != M * DM || out_size != M * DM || ws_size < WS_END) { fprintf(stderr, "kernel_launch: shape/workspace mismatch (n_in %d, in0 %d, out %d, ws %zu; need ws >= %zu); nothing launched\n", n_in, n_in > 0 ? in_sizes[0] : -1, out_size, ws_size, (size_t)WS_END); grid = -1; return; }
        int dev = 0, cus = 0, per_cu = 0;
        if (hipGetDevice(&dev) != hipSuccess || hipDeviceGetAttribute(&cus, hipDeviceAttributeMultiprocessorCount, dev) != hipSuccess) { fprintf(stderr, "kernel_launch: device query failed\n"); grid = -1; return; }
        if (hipFuncSetAttribute((const void*)fwd, hipFuncAttributeMaxDynamicSharedMemorySize, LDS_BYTES) != hipSuccess) { fprintf(stderr, "kernel_launch: hipFuncSetAttribute(%d B LDS) failed\n", LDS_BYTES); grid = -1; return; }
        if (hipOccupancyMaxActiveBlocksPerMultiprocessor(&per_cu, (const void*)fwd, NWAVES * 64, LDS_BYTES) != hipSuccess || per_cu < 1) { fprintf(stderr, "kernel_launch: occupancy query reports %d workgroups per CU\n", per_cu); }
        (void)hipGetLastError();
        grid = cus;
    }
    if (grid < 0) return;
    if (hipMemsetAsync((char*)d_ws + WS_CTL, 0, CTL_ZERO_BYTES, stream) != hipSuccess) { fprintf(stderr, "kernel_launch: memset failed\n"); return; }
    Args a{};
    for (int i = 0; i < 13; ++i) a.in[i] = (const float*)d_in[i];
    a.out = (float*)d_out; a.ws = (unsigned char*)d_ws; a.grid = grid; a.pad = 0;
#if MK_N_LAUNCHES == 1
    a.ph_lo = 0; a.ph_hi = NPH;
    hipLaunchKernelGGL(fwd, dim3(grid), dim3(NWAVES * 64), LDS_BYTES, stream, a);
#else
    for (int p = 0; p < NPH; ++p) { a.ph_lo = p; a.ph_hi = p + 1; hipLaunchKernelGGL(fwd, dim3(grid), dim3(NWAVES * 64), LDS_BYTES, stream, a); }
#endif
    const hipError_t le = hipPeekAtLastError();
    if (le != hipSuccess) fprintf(stderr, "kernel_launch: launch failed: %s\n", hipGetErrorName(le));
}
```

```cpp
#include <hip/hip_runtime.h>
#include <cstdio>
#include <cstdint>
#include <cfloat>
namespace pg8 {
#define PG8_LAS __attribute__((address_space(3)))
typedef unsigned short bf16_t;
typedef short bf16x8 __attribute__((ext_vector_type(8)));
typedef float f32x4 __attribute__((ext_vector_type(4)));
typedef unsigned u32x4 __attribute__((ext_vector_type(4)));
typedef int i32x8 __attribute__((ext_vector_type(8)));
typedef int i32x4 __attribute__((ext_vector_type(4)));
__device__ __forceinline__ i32x8 f8cat(bf16x8 lo, bf16x8 hi) { const i32x4 a = __builtin_bit_cast(i32x4, lo), b = __builtin_bit_cast(i32x4, hi); return __builtin_shufflevector(a, b, 0, 1, 2, 3, 4, 5, 6, 7); }
constexpr int BM = 256, BK = 64, HALF = 128, HTB = HALF * BK * 2  , STAGE_BYTES = 8 * HTB, NXCD = 8, WGM = 8;

__host__ __device__ __forceinline__ int lds_byte(int r, int c) { const int st = (r >> 4) * 2 + (c >> 5), rr = r & 15, cc = c & 31, ob = rr * 64 + cc * 2; return st * 1024 + (ob ^ (((ob >> 9) & 1) << 5)); }
__host__ __device__ __forceinline__ void stage_rc(int b, int& R, int& C) { const int st = b / 1024, sb = b % 1024, swz = sb ^ (((sb >> 9) & 1) << 5); R = (st >> 1) * 16 + swz / 64; C = (st & 1) * 32 + (swz % 64) / 2; }
__host__ __device__ __forceinline__ int perm32(int rho) { const int n = rho >> 4, i = rho & 15; return 8 * (i >> 2) + 4 * n + (i & 3); }

struct Unit { int pm, pn, ui; };
struct Gemm { const bf16_t* A; const bf16_t* Bt; int M, N, K; };

struct StaticOrder {
    int nM, nN, nwg, G, c;
    __host__ __device__ void init(int M, int N, int G_, int c_) { nM = M / BM; nN = N / BM; nwg = nM * nN; G = G_; c = c_; }
    __host__ __device__ bool next(int i, Unit& u) const {
        const long L = (long)i * G + c; if (L >= nwg) return false;
        int wgid = (int)L; { const int q = nwg / NXCD, r = nwg % NXCD, xcd = wgid % NXCD, off = wgid / NXCD; wgid = (xcd < r ? xcd * (q + 1) : r * (q + 1) + (xcd - r) * q) + off; }
        const int nig = WGM * nN, gid = wgid / nig, fm = gid * WGM, gsz = (nM - fm) < WGM ? (nM - fm) : WGM;
        u.pm = fm + ((wgid % nig) % gsz); u.pn = (wgid % nig) / gsz; return true;
    }
    __device__ __forceinline__ void a_ready(const Unit&) const {}
    __device__ __forceinline__ void done(const Unit&) const {}
};
template <int NN>
struct DenseOrder {
    static constexpr int TG = NN / 8, PG = 8 / TG, PPR = 4 * PG;
    int pm_lo, npm, G, c, desc;
    __host__ __device__ void init(int pm_lo_, int npm_, int G_, int c_, int desc_) { pm_lo = pm_lo_; npm = npm_; G = G_; c = c_; desc = desc_; }
    __host__ __device__ bool next(int i, Unit& u) const {
        if (G != 256 || npm % PPR) { const long L = (long)i * G + c; if (L >= (long)npm * NN) return false; u.pm = pm_lo + (int)(L / NN); u.pn = (int)(L % NN); return true; }
        if (i * PPR >= npm) return false;
        const int x = c & 7, s = c >> 3, r = desc ? npm / PPR - 1 - i : i;
        u.pm = pm_lo + r * PPR + (x % PG) * 4 + (s >> 3); u.pn = (x / PG) * 8 + (s & 7); return true;
    }
    __device__ __forceinline__ void a_ready(const Unit&) const {}
    __device__ __forceinline__ void done(const Unit&) const {}
};
struct QkvOrder {
    int G, c;
    __host__ __device__ void init(int G_, int c_) { G = G_; c = c_; }
    __host__ __device__ bool next(int i, Unit& u) const {
        if (G != 256) { const long L = (long)i * G + c; if (L >= 64L * 30) return false; u.pm = (int)(L / 30); u.pn = (int)(L % 30); return true; }
        const int x = c & 7, s = c >> 3; if (s >= 30 || i >= 8) return false;
        u.pm = 8 * i + 2 * (x & 3) + s / 15; u.pn = 15 * (x >> 2) + s % 15; return true;
    }
    __device__ __forceinline__ void a_ready(const Unit&) const {}
    __device__ __forceinline__ void done(const Unit&) const {}
};
struct IdxOrder {
    int G, c;
    __host__ __device__ void init(int G_, int c_) { G = G_; c = c_; }
    __host__ __device__ bool next(int i, Unit& u) const {
        if (G != 256) { const long L = (long)i * G + c; if (L >= 64L * 5) return false; u.pm = (int)(L / 5); u.pn = (int)(L % 5); return true; }
        const int x = c & 7, s = c >> 3; int q;
        if (s >= 30) { if (i >= 5) return false; q = i * 16 + x * 2 + (s - 30); } else { if (i >= 1) return false; q = 80 + x * 30 + s; }
        u.pm = q / 5; u.pn = q % 5; return true;
    }
    __device__ __forceinline__ void a_ready(const Unit&) const {}
    __device__ __forceinline__ void done(const Unit&) const {}
};
struct WeightStationaryOrder {
    int G, c, desc;
    __host__ __device__ void init(int G_, int c_, int desc_) { G = G_; c = c_; desc = desc_; }
    __host__ __device__ bool next(int i, Unit& u) const {
        if (G != 256) { const long L = (long)i * G + c; if (L >= 64L * 32) return false; u.pm = (int)(L / 32); u.pn = (int)(L % 32); return true; }
        if (i >= 8) return false;
        const int x = c & 7, s = c >> 3, r = desc ? 7 - i : i; u.pm = r * 8 + (s >> 2); u.pn = x * 4 + (s & 3); return true;
    }
    __device__ __forceinline__ void a_ready(const Unit&) const {}
    __device__ __forceinline__ void done(const Unit&) const {}
};
struct RowPanelOrder {
    int nM, nN, G, v;
    __host__ __device__ void init(int M, int N, int G_, int v_) { nM = M / BM; nN = N / BM; G = G_; v = v_; }
    __host__ __device__ bool next(int i, Unit& u) const {
        if (G != 4 * nM || (nN & 3)) { const long L = (long)i * G + v; if (L >= (long)nM * nN) return false; u.pm = (int)(L / nN); u.pn = (int)(L % nN); return true; }
        const int per = nN >> 2; if (i >= per) return false; u.pm = v >> 2; u.pn = (v & 3) * per + i; return true;
    }
    __device__ __forceinline__ void a_ready(const Unit&) const {}
    __device__ __forceinline__ void done(const Unit&) const {}
};
struct BalancedOrder {
    StaticOrder base; int full, split, tail_per; bool low;
    __host__ __device__ void init(int M, int N, int G_, int c_, int full_, int split_, int tail_per_, bool low_) { base.init(M, N, G_, c_); full = full_; split = split_; tail_per = tail_per_; low = low_; }
    __host__ __device__ bool next(int i, Unit& u) const {
        if (i < full) return base.next(i, u);
        const int j = i - full; if (j >= tail_per) return false;
        const int c = base.c, G = base.G; int idx;
        if (low) { if (c >= split) return false; idx = j * split + c; } else { if (c < split) return false; idx = j * (G - split) + (c - split); }
        StaticOrder t = base; t.c = 0; t.G = 1;
        return t.next(full * G + idx, u);
    }
    __device__ __forceinline__ void a_ready(const Unit&) const {}
    __device__ __forceinline__ void done(const Unit&) const {}
};

__device__ __forceinline__ unsigned cvt_pk_bf16(float lo, float hi) { unsigned r; asm volatile("v_cvt_pk_bf16_f32 %0, %1, %2" : "=v"(r) : "v"(lo), "v"(hi)); return r; }
__device__ __forceinline__ u32x4 pack8(const f32x4 a, const f32x4 b) { u32x4 w; w.x = cvt_pk_bf16(a[0], a[1]); w.y = cvt_pk_bf16(a[2], a[3]); w.z = cvt_pk_bf16(b[0], b[1]); w.w = cvt_pk_bf16(b[2], b[3]); return w; }
__device__ __forceinline__ void unpack8(const u32x4 w, f32x4& a, f32x4& b) {
    a[0] = __uint_as_float(w.x << 16); a[1] = __uint_as_float(w.x & 0xffff0000u); a[2] = __uint_as_float(w.y << 16); a[3] = __uint_as_float(w.y & 0xffff0000u);
    b[0] = __uint_as_float(w.z << 16); b[1] = __uint_as_float(w.z & 0xffff0000u); b[2] = __uint_as_float(w.w << 16); b[3] = __uint_as_float(w.w & 0xffff0000u); }
__device__ __forceinline__ unsigned pk4_fp8(float a, float b, float c, float d) { int v = 0; v = __builtin_amdgcn_cvt_pk_fp8_f32(a, b, v, false); v = __builtin_amdgcn_cvt_pk_fp8_f32(c, d, v, true); return (unsigned)v; }
__device__ __forceinline__ float sigmoidf_(float x) { return __builtin_amdgcn_rcpf(1.0f + __builtin_amdgcn_exp2f(-1.4426950408889634f * x)); }

__device__ __forceinline__ void row_scalars(const float* p, int row0, float (&rs)[2][4]) {
#pragma unroll
    for (int ai = 0; ai < 2; ++ai)
#pragma unroll
        for (int m = 0; m < 4; ++m) rs[ai][m] = p[row0 + ai * HALF + m * 16];
    asm volatile("" : "+v"(rs[0][0]), "+v"(rs[0][1]), "+v"(rs[0][2]), "+v"(rs[0][3]), "+v"(rs[1][0]), "+v"(rs[1][1]), "+v"(rs[1][2]), "+v"(rs[1][3]) :: "memory");
}
constexpr float QKB_PRESCALE = 0.088388347648318440f * 1.4426950408889634f;
struct EpiQKV {
    static constexpr bool PERM = true, AFTER_DRAIN = false; static constexpr int HOOK_T = -1;
    float asc  ; bf16_t* QV; bf16_t* KAF; size_t kbf_delta  ; const float* rstd0;
    __device__ __forceinline__ void hook(f32x4 (&)[2][2][4][2], const Unit&, int, int, int, int) const {}
    __device__ __forceinline__ void operator()(const f32x4 (&acc)[2][2][4][2], const Unit& u, int wr, int wc, int fr, int fq) const {
        const int row0 = u.pm * BM + wr * 64 + fr, pn = u.pn;
        float rsv[2][4]; row_scalars(rstd0, row0, rsv);
        const bool is_ka = (pn >= 6 && pn < 12), is_kb = (pn >= 22 && pn < 26);
        if (is_ka || is_kb) {
            const int d0 = 2 * wc + (fq >> 1), hi = fq & 1;
#pragma unroll
            for (int ai = 0; ai < 2; ++ai)
#pragma unroll
                for (int m = 0; m < 4; ++m) { const int row = row0 + ai * HALF + m * 16; const float rs = rsv[ai][m] * asc; const int b = row >> 11, t = row & 2047;
#pragma unroll
                    for (int bj = 0; bj < 2; ++bj) { size_t off;
                        if (is_kb) { const int head = 2 * pn + bj - 44; off = ((size_t)(((b * 8 + head) * 64 + (t >> 5)) * 8 + d0)) * 512 + ((t & 31) + 32 * hi) * 8; }
                        else { const int gh = 2 * pn + bj - 12, g = gh >> 2, dsh = 2 * g, r = t & ((1 << dsh) - 1), p = t >> dsh;
                               off = ((size_t)((((b * 3 + g) * 4 + (gh & 3)) * 64 + r * (64 >> dsh) + (p >> 5)) * 8 + d0)) * 512 + ((p & 31) + 32 * hi) * 8; }
                        if (is_kb) off += kbf_delta;
                        *(u32x4*)(KAF + off) = pack8(acc[ai][bj][m][0] * rs, acc[ai][bj][m][1] * rs); } }
        } else {
            const int col0 = (pn < 6 ? pn : pn < 22 ? pn - 6 : pn - 10) * BM + wc * 32 + 8 * fq;
            const float qsc = (pn < 6 || (pn >= 18 && pn < 22)) ? QKB_PRESCALE : 1.0f;
#pragma unroll
            for (int ai = 0; ai < 2; ++ai)
#pragma unroll
                for (int m = 0; m < 4; ++m) { const int row = row0 + ai * HALF + m * 16; const float rs = rsv[ai][m] * asc * qsc; bf16_t* rowp = QV + (size_t)row * 5120 + col0;
#pragma unroll
                    for (int bj = 0; bj < 2; ++bj) *(u32x4*)(rowp + bj * HALF) = pack8(acc[ai][bj][m][0] * rs, acc[ai][bj][m][1] * rs); }
        }
    }
};
template <size_t O_QI, size_t O_KI, size_t O_WI, size_t O_RSTD> struct EpiIdx {
    static constexpr bool PERM = true, AFTER_DRAIN = false; static constexpr int HOOK_T = -1;
    unsigned char* ws; const float* lng; const float* lnb;
    __device__ __forceinline__ void hook(f32x4 (&)[2][2][4][2], const Unit&, int, int, int, int) const {}
    __device__ __forceinline__ void operator()(const f32x4 (&acc)[2][2][4][2], const Unit& u, int wr, int wc, int fr, int fq) const {
        bf16_t* QI = (bf16_t*)(ws + O_QI); bf16_t* KI = (bf16_t*)(ws + O_KI); float* WI = (float*)(ws + O_WI); const float* rstd0 = (const float*)(ws + O_RSTD);
        const int row0 = u.pm * BM + wr * 64 + fr, pn = u.pn + 30; const float asc = 1.0f;
        float rsv[2][4]; row_scalars(rstd0, row0, rsv);
        if (pn < 34) {
            bf16_t* base = QI; const int ldc = 1024, colt = (pn - 30) * BM; const float sc = 0.125f;
            const int col0 = colt + wc * 32 + 8 * fq;
#pragma unroll
            for (int ai = 0; ai < 2; ++ai)
#pragma unroll
                for (int m = 0; m < 4; ++m) { const int row = row0 + ai * HALF + m * 16; const float rs = rsv[ai][m] * sc; bf16_t* rowp = base + (size_t)row * ldc + col0;
#pragma unroll
                    for (int bj = 0; bj < 2; ++bj) *(u32x4*)(rowp + bj * HALF) = pack8(acc[ai][bj][m][0] * rs, acc[ai][bj][m][1] * rs); }
        } else if (wc == 0) {
            f32x4 g0[2], g1[2], b0[2], b1[2];
#pragma unroll
            for (int n = 0; n < 2; ++n) { g0[n] = *(const f32x4*)(lng + 8 * fq + 4 * n); g1[n] = *(const f32x4*)(lng + 32 + 8 * fq + 4 * n); b0[n] = *(const f32x4*)(lnb + 8 * fq + 4 * n); b1[n] = *(const f32x4*)(lnb + 32 + 8 * fq + 4 * n); }
#pragma unroll
            for (int ai = 0; ai < 2; ++ai)
#pragma unroll
                for (int m = 0; m < 4; ++m) { const int row = row0 + ai * HALF + m * 16; const float rs = rsv[ai][m] * asc;
                    f32x4 v[2][2]; float s = 0.f;
#pragma unroll
                    for (int bj = 0; bj < 2; ++bj)
#pragma unroll
                        for (int n = 0; n < 2; ++n) { v[bj][n] = acc[ai][bj][m][n] * rs; s += (v[bj][n][0] + v[bj][n][1]) + (v[bj][n][2] + v[bj][n][3]); }
                    s += __shfl_xor(s, 16); s += __shfl_xor(s, 32);
                    const float mean = s * (1.0f / 64.0f); float q = 0.f;
#pragma unroll
                    for (int bj = 0; bj < 2; ++bj)
#pragma unroll
                        for (int n = 0; n < 2; ++n) { v[bj][n] = v[bj][n] - mean; q += (v[bj][n][0] * v[bj][n][0] + v[bj][n][1] * v[bj][n][1]) + (v[bj][n][2] * v[bj][n][2] + v[bj][n][3] * v[bj][n][3]); }
                    q += __shfl_xor(q, 16); q += __shfl_xor(q, 32);
                    const float rstd = 1.0f / sqrtf(q * (1.0f / 64.0f) + 1e-6f);
                    bf16_t* rowp = KI + (size_t)(row >> 5) * 2048 + (fq >> 1) * 512 + ((row & 31) + 32 * (fq & 1)) * 8;
                    *(u32x4*)(rowp) = pack8(v[0][0] * rstd * g0[0] + b0[0], v[0][1] * rstd * g0[1] + b0[1]);
                    *(u32x4*)(rowp + 1024) = pack8(v[1][0] * rstd * g1[0] + b1[0], v[1][1] * rstd * g1[1] + b1[1]); }
        } else if (wc == 1) {
            if (fq < 2) {
#pragma unroll
                for (int ai = 0; ai < 2; ++ai)
#pragma unroll
                    for (int m = 0; m < 4; ++m) { const int row = row0 + ai * HALF + m * 16; const float rs = rsv[ai][m] * 0.25f * asc; float* rowp = WI + (size_t)row * 16 + 8 * fq;
                        *(f32x4*)(rowp) = acc[ai][0][m][0] * rs; *(f32x4*)(rowp + 4) = acc[ai][0][m][1] * rs; }
            }
        }
    }
};
struct EpiGate {
    static constexpr bool PERM = true, AFTER_DRAIN = false; static constexpr int HOOK_T = -1;
    bf16_t* R; bf16_t* SB; long r_hi, sb_hi  ; const float* rstd0; float asc;
    __device__ __forceinline__ void hook(f32x4 (&)[2][2][4][2], const Unit&, int, int, int, int) const {}
    __device__ __forceinline__ void operator()(const f32x4 (&acc)[2][2][4][2], const Unit& u, int wr, int wc, int fr, int fq) const {
        const int row0 = u.pm * BM + wr * 64 + fr, col0 = u.pn * HALF + wc * 32 + 8 * fq;
        float rsv[2][4]; row_scalars(rstd0, row0, rsv);
        bf16_t* Rb = R + (u.pm >= 32 ? r_hi : 0L); bf16_t* Sb = SB + (u.pm >= 32 ? sb_hi : 0L);
#pragma unroll
        for (int ai = 0; ai < 2; ++ai)
#pragma unroll
            for (int m = 0; m < 4; ++m) { const int row = row0 + ai * HALF + m * 16; const float rs = rsv[ai][m] * asc; const size_t off = (size_t)row * 2048 + col0;
                f32x4 r0, r1, s0, s1;
                const float nrs = -1.4426950408889634f * rs;
#pragma unroll
                for (int j = 0; j < 4; ++j) { const float da0 = 1.0f + __builtin_amdgcn_exp2f(acc[ai][0][m][0][j] * nrs), da1 = 1.0f + __builtin_amdgcn_exp2f(acc[ai][0][m][1][j] * nrs);
                    const float db0 = 1.0f + fminf(__builtin_amdgcn_exp2f(acc[ai][1][m][0][j] * nrs), 1e20f), db1 = 1.0f + fminf(__builtin_amdgcn_exp2f(acc[ai][1][m][1][j] * nrs), 1e20f);
                    s0[j] = __builtin_amdgcn_rcpf(db0); s1[j] = __builtin_amdgcn_rcpf(db1);
                    r0[j] = db0 * __builtin_amdgcn_rcpf(da0); r1[j] = db1 * __builtin_amdgcn_rcpf(da1); }
                *(u32x4*)(Rb + off) = pack8(r0, r1); *(u32x4*)(Sb + off) = pack8(s0, s1); }
    }
};
template <int HT> struct EpiMerged {
    static constexpr bool PERM = true, AFTER_DRAIN = false; static constexpr int HOOK_T = HT;
    unsigned char* MG; const bf16_t* R; const bf16_t* SB; long r_hi, sb_hi  ; float osc;
    __device__ __forceinline__ void hook(f32x4 (&acc)[2][2][4][2], const Unit& u, int wr, int wc, int fr, int fq) const {
        unsigned o0 = (unsigned)(u.pm * BM + wr * 64 + fr) * 2048u + (unsigned)(u.pn * BM + wc * 32 + 8 * fq); asm volatile("" : "+v"(o0));
        const bf16_t* Rb = R + (u.pm >= 32 ? r_hi : 0L);
        u32x4 w[2][4][2];
#pragma unroll
        for (int ai = 0; ai < 2; ++ai)
#pragma unroll
            for (int m = 0; m < 4; ++m)
#pragma unroll
                for (int bj = 0; bj < 2; ++bj) w[ai][m][bj] = *(const u32x4*)(Rb + o0 + (unsigned)((ai * HALF + m * 16) * 2048) + bj * HALF);
#pragma unroll
        for (int ai = 0; ai < 2; ++ai)
#pragma unroll
            for (int m = 0; m < 4; ++m)
#pragma unroll
                for (int bj = 0; bj < 2; ++bj) { f32x4 a0, a1; unpack8(w[ai][m][bj], a0, a1); acc[ai][bj][m][0] *= a0; acc[ai][bj][m][1] *= a1; }
    }
    __device__ __forceinline__ void operator()(const f32x4 (&acc)[2][2][4][2], const Unit& u, int wr, int wc, int fr, int fq) const {
        unsigned o0 = (unsigned)(u.pm * BM + wr * 64 + fr) * 2048u + (unsigned)(u.pn * BM + wc * 32 + 8 * fq); asm volatile("" : "+v"(o0));
        const bf16_t* Sb = SB + (u.pm >= 32 ? sb_hi : 0L);
        u32x4 w[2][4][2];
#pragma unroll
        for (int ai = 0; ai < 2; ++ai)
#pragma unroll
            for (int m = 0; m < 4; ++m)
#pragma unroll
                for (int bj = 0; bj < 2; ++bj) w[ai][m][bj] = *(const u32x4*)(Sb + o0 + (unsigned)((ai * HALF + m * 16) * 2048) + bj * HALF);
        asm volatile("" ::: "memory");
#pragma unroll
        for (int ai = 0; ai < 2; ++ai)
#pragma unroll
            for (int m = 0; m < 4; ++m) { const unsigned o = o0 + (unsigned)((ai * HALF + m * 16) * 2048);
#pragma unroll
                for (int bj = 0; bj < 2; ++bj) { f32x4 b0, b1; unpack8(w[ai][m][bj], b0, b1);
                    const f32x4 v0 = acc[ai][bj][m][0] * b0 * osc, v1 = acc[ai][bj][m][1] * b1 * osc; typedef unsigned u32x2 __attribute__((ext_vector_type(2)));
                    *(u32x2*)(MG + o + bj * HALF) = (u32x2){pk4_fp8(v0[0], v0[1], v0[2], v0[3]), pk4_fp8(v1[0], v1[1], v1[2], v1[3])}; } }
    }
};
struct EpiResid {
    static constexpr bool PERM = true, AFTER_DRAIN = false; static constexpr int HOOK_T = -1;
    bf16_t* resb; float* ss; float asc;
    __device__ __forceinline__ void hook(f32x4 (&)[2][2][4][2], const Unit&, int, int, int, int) const {}
    __device__ __forceinline__ void operator()(const f32x4 (&acc)[2][2][4][2], const Unit& u, int wr, int wc, int fr, int fq) const {
        const int row0 = u.pm * BM + wr * 64 + fr;
        unsigned o0 = (unsigned)row0 * 2048u + (unsigned)(u.pn * BM + wc * 32 + 8 * fq); asm volatile("" : "+v"(o0));
        float sq[2][4];
        u32x4 rb[2][4][2];
#pragma unroll
        for (int ai = 0; ai < 2; ++ai)
#pragma unroll
            for (int m = 0; m < 4; ++m)
#pragma unroll
                for (int bj = 0; bj < 2; ++bj) rb[ai][m][bj] = *(const u32x4*)(resb + o0 + (unsigned)((ai * HALF + m * 16) * 2048) + bj * HALF);
        asm volatile("" ::: "memory");
#pragma unroll
        for (int ai = 0; ai < 2; ++ai)
#pragma unroll
            for (int m = 0; m < 4; ++m) { const unsigned o = o0 + (unsigned)((ai * HALF + m * 16) * 2048); float s = 0.f;
#pragma unroll
                for (int bj = 0; bj < 2; ++bj) { f32x4 r0, r1; unpack8(rb[ai][m][bj], r0, r1); const f32x4 v0 = r0 + acc[ai][bj][m][0] * asc, v1 = r1 + acc[ai][bj][m][1] * asc;
                    *(u32x4*)(resb + o + bj * HALF) = pack8(v0, v1);
                    s += (v0[0] * v0[0] + v0[1] * v0[1]) + (v0[2] * v0[2] + v0[3] * v0[3]) + (v1[0] * v1[0] + v1[1] * v1[1]) + (v1[2] * v1[2] + v1[3] * v1[3]); }
                s += __shfl_xor(s, 16); s += __shfl_xor(s, 32); sq[ai][m] = s; }
#pragma unroll
        for (int ai = 0; ai < 2; ++ai)
#pragma unroll
            for (int m = 0; m < 4; ++m) if (fq == 0) unsafeAtomicAdd(ss + row0 + ai * HALF + m * 16, sq[ai][m]);
    }
};
struct EpiUp {
    static constexpr bool PERM = true, AFTER_DRAIN = false; static constexpr int HOOK_T = -1;
    bf16_t* H; const float* ss1;
    __device__ __forceinline__ void hook(f32x4 (&)[2][2][4][2], const Unit&, int, int, int, int) const {}
    __device__ __forceinline__ void operator()(const f32x4 (&acc)[2][2][4][2], const Unit& u, int wr, int wc, int fr, int fq) const {
        const int row0 = u.pm * BM + wr * 64 + fr;
        bf16_t* base = H + (size_t)u.pm * (BM * 8192) + (size_t)(u.pn * 4 + (wc >> 1)) * (BM * 64) + (unsigned)(wr * 8192 + (wc & 1) * 1024 + ((fr * 64 + 16 * fq) ^ ((fr >> 3) << 5))) / 2u;
        float rsv[2][4]; row_scalars(ss1, row0, rsv);
#pragma unroll
        for (int ai = 0; ai < 2; ++ai)
#pragma unroll
            for (int m = 0; m < 4; ++m) { const float r2 = 1.0f / (rsv[ai][m] * (1.0f / 2048.0f) + 1e-6f); bf16_t* rowp = base + ai * 8192 + m * 1024;
#pragma unroll
                for (int bj = 0; bj < 2; ++bj) { f32x4 v0 = acc[ai][bj][m][0], v1 = acc[ai][bj][m][1];
#pragma unroll
                    for (int j = 0; j < 4; ++j) { const float a = fmaxf(v0[j], 0.f), b = fmaxf(v1[j], 0.f); v0[j] = a * a * r2; v1[j] = b * b * r2; }
                    *(u32x4*)(rowp + bj * (2 * BM * 64)) = pack8(v0, v1); } }
    }
};
template <class Epi, class Sched, bool ALIGN_EPI = false, bool SP2 = false, bool FP8 = false, bool ATILED = false>
__device__ __forceinline__ void gemm_phase(PG8_LAS unsigned char* lds, const Gemm g, const Sched& S, const Epi& E) {
    int tid_o = threadIdx.x; asm volatile("" : "+v"(tid_o));
    const int tid = tid_o, wid = __builtin_amdgcn_readfirstlane(tid >> 6), lane = tid & 63, wr = wid >> 2, wc = wid & 3, fr = lane & 15, fq = lane >> 4;
    const int K = g.K, nt = K / BK;
    unsigned voffA[2], voffB[2];
#pragma unroll
    for (int i = 0; i < 2; ++i) { int R, C; stage_rc(tid * 16 + i * 8192, R, C); const int Rb = Epi::PERM ? ((R & ~31) + perm32(R & 31)) : R;
        voffA[i] = ATILED ? (unsigned)(tid * 16 + i * 8192) : (unsigned)(R * K + C) * 2u; voffB[i] = (unsigned)(Rb * K + C) * 2u; }
    const size_t kstep = (size_t)(BK * 2);
    const size_t hstep = (size_t)HALF * K * 2;
    const size_t tstep = 2 * hstep;
    const size_t kstepA = ATILED ? (size_t)(BM * BK * 2) : kstep, hstepA = ATILED ? (size_t)(HALF * BK * 2) : hstep, pstepA = ATILED ? (size_t)(64 * BK * 2) : (size_t)64 * K * 2;
    const unsigned ldsw = (unsigned)wid * 1024u;
    const int aoff = lds_byte(wr * 64 + fr, fq * 8), boff = lds_byte(wc * 32 + fr, fq * 8);
#define PG8_SA(b, h) (((b) * 2 + (h)) * HTB)
#define PG8_SB(b, h) ((4 + (b) * 2 + (h)) * HTB)
#define PG8_STAGEX(bufoff, gbase, voff, pstep) do { _Pragma("unroll") for (int _i = 0; _i < 2; ++_i) { unsigned vo_ = (voff)[0]; asm volatile("" : "+v"(vo_)); \
        __builtin_amdgcn_global_load_lds((const unsigned*)((const char*)(gbase) + (size_t)_i * (pstep) + vo_), (PG8_LAS unsigned*)(lds + (bufoff) + ldsw + _i * 8192), 16, 0, 0); } } while (0)
#define PG8_STAGE(bufoff, gbase, voff) PG8_STAGEX(bufoff, gbase, voff, (size_t)64 * K * 2)
#define PG8_STAGEA(bufoff, gbase, voff) PG8_STAGEX(bufoff, gbase, voff, pstepA)
#define PG8_LDA(dst, b, h) do { _Pragma("unroll") for (int m = 0; m < 4; ++m) _Pragma("unroll") for (int k = 0; k < 2; ++k) dst[m][k] = *(const PG8_LAS bf16x8*)(lds + PG8_SA(b, h) + aoff + m * 2048 + k * 1024); } while (0)
#define PG8_LDB(dst, b, h) do { _Pragma("unroll") for (int n = 0; n < 2; ++n) _Pragma("unroll") for (int k = 0; k < 2; ++k) dst[n][k] = *(const PG8_LAS bf16x8*)(lds + PG8_SB(b, h) + boff + n * 2048 + k * 1024); } while (0)
#define PG8_F8(X) f8cat((X)[0], (X)[1])
#define PG8_MMA(ai, bj, At, Bt) do { __builtin_amdgcn_s_setprio(1); _Pragma("unroll") for (int m = 0; m < 4; ++m) _Pragma("unroll") for (int n = 0; n < 2; ++n) { \
        if constexpr (FP8) acc[ai][bj][m][n] = __builtin_amdgcn_mfma_scale_f32_16x16x128_f8f6f4(PG8_F8(Bt[n]), PG8_F8(At[m]), acc[ai][bj][m][n], 0, 0, 0, 0, 0, 0); \
        else { _Pragma("unroll") for (int k = 0; k < 2; ++k) acc[ai][bj][m][n] = __builtin_amdgcn_mfma_f32_16x16x32_bf16(Bt[n][k], At[m][k], acc[ai][bj][m][n], 0, 0, 0); } } __builtin_amdgcn_s_setprio(0); } while (0)
#define PG8_WAIT_V(n) asm volatile("s_waitcnt vmcnt(" #n ")" ::: "memory")
#define PG8_WAIT_L(n) asm volatile("s_waitcnt lgkmcnt(" #n ")" ::: "memory")
#define PG8_BAR __builtin_amdgcn_s_barrier()
#define PG8_SCHED __builtin_amdgcn_sched_barrier(0)
    Unit cur, nxt; int ui = 0;
    if (!S.next(0, cur)) return;
    cur.ui = 0;
    f32x4 acc[2][2][4][2];
#pragma unroll
    for (int a = 0; a < 2; ++a)
#pragma unroll
        for (int b = 0; b < 2; ++b)
#pragma unroll
            for (int m = 0; m < 4; ++m)
#pragma unroll
                for (int n = 0; n < 2; ++n) acc[a][b][m][n] = (f32x4){0.f, 0.f, 0.f, 0.f};
    bf16x8 At[4][2], B0[2][2], B1[2][2];
    const char* cA = (const char*)g.A + (size_t)cur.pm * tstep; const char* cB = (const char*)g.Bt + (size_t)cur.pn * tstep;
    S.a_ready(cur);
    if constexpr (SP2) {
        PG8_STAGE(PG8_SB(0, 0), cB, voffB); PG8_STAGE(PG8_SB(0, 1), cB + hstep, voffB); PG8_STAGEA(PG8_SA(0, 0), cA, voffA); PG8_STAGEA(PG8_SA(0, 1), cA + hstepA, voffA);
        if (wr == 1) PG8_BAR;
        PG8_WAIT_V(2); PG8_BAR;
        PG8_STAGE(PG8_SB(1, 0), cB + kstep, voffB); PG8_STAGEA(PG8_SA(1, 0), cA + kstepA, voffA); PG8_STAGE(PG8_SB(1, 1), cB + hstep + kstep, voffB);
        PG8_WAIT_V(6); PG8_BAR;
    } else {
        PG8_STAGE(PG8_SB(0, 0), cB, voffB); PG8_STAGEA(PG8_SA(0, 0), cA, voffA); PG8_STAGE(PG8_SB(0, 1), cB + hstep, voffB); PG8_STAGEA(PG8_SA(0, 1), cA + hstepA, voffA);
        if (wr == 1) PG8_BAR;
        PG8_WAIT_V(4); PG8_BAR;
        PG8_STAGE(PG8_SB(1, 0), cB + kstep, voffB); PG8_STAGEA(PG8_SA(1, 0), cA + kstepA, voffA); PG8_STAGE(PG8_SB(1, 1), cB + hstep + kstep, voffB);
        PG8_WAIT_V(6); PG8_BAR;
    }
    for (;;) {
        const bool has_next = S.next(ui + 1, nxt); nxt.ui = ui + 1;
        const char* nA = has_next ? (const char*)g.A + (size_t)nxt.pm * tstep : cA; const char* nB = has_next ? (const char*)g.Bt + (size_t)nxt.pn * tstep : cB;
        constexpr int NSEG = (Epi::HOOK_T >= 0) ? 2 : 1;
#pragma unroll 1
        for (int seg = 0; seg < NSEG; ++seg) {
        const int t_lo = (seg == 0) ? 0 : Epi::HOOK_T, t_hi = (NSEG == 2 && seg == 0) ? Epi::HOOK_T : nt;
        if (seg == 1) { int t_o = threadIdx.x; asm volatile("" : "+v"(t_o)); E.hook(acc, cur, wr, wc, t_o & 15, (t_o >> 4) & 3); }
#pragma unroll 1
        for (int t = t_lo; t < t_hi; t += 2) {
            const bool last = (t == nt - 2);
            const char* a1 = cA + (size_t)(t + 1) * kstepA;
            const char* a2 = last ? nA : cA + (size_t)(t + 2) * kstepA; const char* b2 = last ? nB : cB + (size_t)(t + 2) * kstep;
            const char* a3 = a2 + kstepA; const char* b3 = b2 + kstep;
            if (last && has_next) S.a_ready(nxt);
            if constexpr (SP2) {
            PG8_LDB(B0, 0, 0); PG8_LDB(B1, 0, 1); PG8_SCHED; PG8_LDA(At, 0, 0); PG8_STAGEA(PG8_SA(1, 1), a1 + hstepA, voffA);
            PG8_WAIT_V(8); PG8_WAIT_L(0); PG8_BAR; PG8_MMA(0, 0, At, B0); PG8_MMA(0, 1, At, B1); PG8_BAR; PG8_SCHED;
            PG8_LDA(At, 0, 1); PG8_STAGE(PG8_SB(0, 0), b2, voffB); PG8_STAGE(PG8_SB(0, 1), b2 + hstep, voffB); PG8_STAGEA(PG8_SA(0, 0), a2, voffA);
            PG8_WAIT_V(8); PG8_WAIT_L(0); PG8_BAR; PG8_MMA(1, 0, At, B0); PG8_MMA(1, 1, At, B1); PG8_BAR; PG8_SCHED;
            PG8_LDB(B0, 1, 0); PG8_LDB(B1, 1, 1); PG8_SCHED; PG8_LDA(At, 1, 0); PG8_STAGEA(PG8_SA(0, 1), a2 + hstepA, voffA);
            PG8_WAIT_V(8); PG8_WAIT_L(0); PG8_BAR; PG8_MMA(0, 0, At, B0); PG8_MMA(0, 1, At, B1); PG8_BAR; PG8_SCHED;
            PG8_LDA(At, 1, 1); PG8_STAGE(PG8_SB(1, 0), b3, voffB); PG8_STAGE(PG8_SB(1, 1), b3 + hstep, voffB); PG8_STAGEA(PG8_SA(1, 0), a3, voffA);
            PG8_WAIT_V(8); PG8_WAIT_L(0); PG8_BAR; PG8_MMA(1, 0, At, B0); PG8_MMA(1, 1, At, B1); PG8_BAR; PG8_SCHED;
            } else {
            PG8_LDB(B0, 0, 0); PG8_SCHED; PG8_LDA(At, 0, 0); PG8_STAGEA(PG8_SA(1, 1), a1 + hstepA, voffA);
            PG8_WAIT_L(8); PG8_BAR; PG8_WAIT_L(0); PG8_MMA(0, 0, At, B0); PG8_BAR; PG8_SCHED;
            PG8_LDB(B1, 0, 1); PG8_STAGE(PG8_SB(0, 0), b2, voffB);
            PG8_BAR; PG8_WAIT_L(0); PG8_MMA(0, 1, At, B1); PG8_BAR;
            PG8_LDA(At, 0, 1); PG8_STAGEA(PG8_SA(0, 0), a2, voffA);
            PG8_BAR; PG8_WAIT_L(0); PG8_MMA(1, 0, At, B0); PG8_BAR; PG8_SCHED;
            PG8_STAGE(PG8_SB(0, 1), b2 + hstep, voffB);
            PG8_WAIT_V(6); PG8_BAR; PG8_MMA(1, 1, At, B1); PG8_BAR;
            PG8_LDB(B0, 1, 0); PG8_SCHED; PG8_LDA(At, 1, 0); PG8_STAGEA(PG8_SA(0, 1), a2 + hstepA, voffA);
            PG8_WAIT_L(8); PG8_BAR; PG8_WAIT_L(0); PG8_MMA(0, 0, At, B0); PG8_BAR; PG8_SCHED;
            PG8_LDB(B1, 1, 1); PG8_STAGE(PG8_SB(1, 0), b3, voffB);
            PG8_BAR; PG8_WAIT_L(0); PG8_MMA(0, 1, At, B1); PG8_BAR;
            PG8_LDA(At, 1, 1); PG8_STAGEA(PG8_SA(1, 0), a3, voffA);
            PG8_BAR; PG8_WAIT_L(0); PG8_MMA(1, 0, At, B0); PG8_BAR; PG8_SCHED;
            PG8_STAGE(PG8_SB(1, 1), b3 + hstep, voffB);
            PG8_WAIT_V(6); PG8_BAR; PG8_MMA(1, 1, At, B1); PG8_BAR;
            }
        }
        }
        if constexpr (ALIGN_EPI) { if (wr == 0) PG8_BAR; }
        if constexpr (!Epi::AFTER_DRAIN) { int t_o = threadIdx.x; asm volatile("" : "+v"(t_o)); E(acc, cur, wr, wc, t_o & 15, (t_o >> 4) & 3); S.done(cur); }
        if (!has_next) break;
#pragma unroll
        for (int a = 0; a < 2; ++a)
#pragma unroll
            for (int b = 0; b < 2; ++b)
#pragma unroll
                for (int m = 0; m < 4; ++m)
#pragma unroll
                    for (int n = 0; n < 2; ++n) acc[a][b][m][n] = (f32x4){0.f, 0.f, 0.f, 0.f};
        cur = nxt; cA = nA; cB = nB; ++ui;
        if constexpr (ALIGN_EPI) { if (wr == 1) PG8_BAR; }
    }
    PG8_WAIT_V(0);
    if constexpr (!ALIGN_EPI) { if (wr == 0) PG8_BAR; }
    PG8_BAR;
    if constexpr (Epi::AFTER_DRAIN) { E.fused(acc, cur, wr, wc, fr, fq, lds, wid, lane); S.done(cur); }
#undef PG8_SA
#undef PG8_SB
#undef PG8_STAGE
#undef PG8_STAGEA
#undef PG8_STAGEX
#undef PG8_LDA
#undef PG8_LDB
#undef PG8_MMA
#undef PG8_F8
#undef PG8_WAIT_V
#undef PG8_WAIT_L
#undef PG8_BAR
#undef PG8_SCHED
}
}

constexpr int NWAVES = 8;
constexpr int BATCH = 8, SEQ = 2048, DM = 2048, DFF = 8192, M = BATCH * SEQ;
constexpr int D_IN = 12880, NQKV = 5120  , NQKV_W = 7680  , N1I = 1280  , N1 = NQKV_W + N1I, NG = 4096, N1T = N1 + NG;
constexpr int KP = 1536;
constexpr float LOG2E = 1.4426950408889634f;
constexpr float QK_C = 0.088388347648318440f * LOG2E;
constexpr float NEGV = -1e30f;
constexpr int NPH = 11;
#ifndef STAGGER_TICKS
#define STAGGER_TICKS 500
#endif
constexpr float W8_SCALE = 64.f, WP8_SCALE = 32.f, O8_SCALE = 16.f;

constexpr size_t MiB = 1u << 20;
constexpr size_t WS_CTL = 0, CTL_ZERO_BYTES = 1 * MiB;
constexpr size_t WS_W1Q8 = 1 * MiB, WS_W1G8 = 16 * MiB, WS_W1I = 24 * MiB, WS_WP8 = 29 * MiB, WS_WO8 = 32 * MiB, WS_WU = 36 * MiB, WS_WD = 68 * MiB;
constexpr size_t WS_X8 = 100 * MiB;
constexpr size_t WS_XB = 132 * MiB;
constexpr size_t WS_BIG = 196 * MiB;
constexpr size_t WS_QKV = WS_BIG, WS_KAF = WS_BIG + 160 * MiB, WS_KBF = WS_BIG + 208 * MiB, WS_QI = WS_BIG + 240 * MiB, WS_KI = WS_BIG + 272 * MiB, WS_WI = WS_BIG + 274 * MiB, WS_MASK = WS_BIG + 275 * MiB;
constexpr size_t WS_MG8 = WS_BIG + 128 * MiB, WS_H = WS_BIG;
constexpr size_t WS_R_LO = WS_KAF, WS_R_HI = WS_QI, WS_SB_LO = WS_BIG + 279 * MiB, G_HALF_BYTES = (size_t)(M / 2) * DM * 2;
constexpr size_t WS_END = 512 * MiB;
static_assert(WS_W1Q8 + (size_t)NQKV_W * DM <= WS_W1G8 && WS_W1G8 + (size_t)NG * DM <= WS_W1I && WS_W1I + (size_t)N1I * DM * 2 <= WS_WP8 && WS_WP8 + (size_t)DM * KP <= WS_WO8 && WS_WO8 + (size_t)DM * DM <= WS_WU && WS_WU + (size_t)DFF * DM * 2 <= WS_WD && WS_WD + (size_t)DM * DFF * 2 <= WS_X8 && WS_X8 + (size_t)M * DM <= WS_XB, "weights map");
static_assert(WS_XB + (size_t)M * DM * 2 <= WS_BIG && WS_QKV + (size_t)M * NQKV * 2 <= WS_KAF && WS_KAF + (size_t)M * 1536 * 2 <= WS_KBF && WS_KBF + (size_t)M * 1024 * 2 <= WS_QI && WS_QI + (size_t)M * 1024 * 2 <= WS_KI && WS_KI + (size_t)M * 64 * 2 <= WS_WI && WS_WI + (size_t)M * 16 * 4 <= WS_MASK && WS_MASK + (size_t)M * 64 * 4 <= WS_END, "activation map");
static_assert(WS_MG8 + (size_t)M * DM <= WS_KAF && WS_H + (size_t)M * DFF * 2 <= WS_END && WS_R_LO + G_HALF_BYTES <= WS_KBF && WS_R_HI + G_HALF_BYTES <= WS_KI && WS_MASK + (size_t)M * 64 * 4 <= WS_SB_LO && WS_SB_LO + G_HALF_BYTES <= WS_END, "overlay map");
constexpr size_t DO_OAP = 0, DO_LSE = 48 * MiB, DO_OAB = 64 * MiB, DO_SB_HI = 88 * MiB  ;
constexpr int CW_BAR = 4096;
constexpr size_t CTL_SS1 = 256 * 1024, CTL_SS2 = 320 * 1024, CTL_RSTD0 = 384 * 1024, CTL_PCNT = 448 * 1024;

constexpr int RING_BYTES = 131072;
constexpr int LDSCTL_OFF = 151552, MISC_OFF = LDSCTL_OFF + 320;
constexpr int LDS_BYTES = 155648;

#define GAS __attribute__((address_space(1)))
#define LAS __attribute__((address_space(3)))
typedef unsigned short bf16;
typedef unsigned v4u __attribute__((ext_vector_type(4)));
typedef float f32x4 __attribute__((ext_vector_type(4)));
typedef float f32x16 __attribute__((ext_vector_type(16)));
typedef short bf16x8 __attribute__((ext_vector_type(8)));
typedef short s16x4 __attribute__((ext_vector_type(4)));
typedef GAS unsigned gu32;
#define LDS_WAIT() asm volatile("s_waitcnt lgkmcnt(0)" ::: "memory")
#define VM_WAIT() asm volatile("s_waitcnt vmcnt(0)" ::: "memory")
#define SBAR() __builtin_amdgcn_sched_barrier(0)
__device__ __forceinline__ unsigned f2bf(float f) { unsigned u = __builtin_bit_cast(unsigned, f); return (u + 0x7fffu + ((u >> 16) & 1u)) >> 16; }
__device__ __forceinline__ unsigned pk2(float lo, float hi) { return f2bf(lo) | (f2bf(hi) << 16); }
__device__ __forceinline__ unsigned cvtpk(float lo, float hi) { unsigned r; asm volatile("v_cvt_pk_bf16_f32 %0, %1, %2" : "=v"(r) : "v"(lo), "v"(hi)); return r; }
__device__ __forceinline__ int crow(int r, int hi) { return (r & 3) + 8 * (r >> 2) + 4 * hi; }
__device__ __forceinline__ float wave_sum(float v) {
#pragma unroll
    for (int o = 1; o < 64; o <<= 1) v += __shfl_xor(v, o);
    return v;
}
__device__ __forceinline__ int t5_bucket(int n) {
    if (n < 16) return n;
    const int l = 16 + (int)(logf((float)n / 16.0f) / 4.852030263919617f * 16.0f);
    return l < 31 ? l : 31;
}
#define XB_TMO      128
#define XB_XCNT(j)  (256  + 64 * (j))
#define XB_XSUB(j)  (1280 + 64 * (j))
#define XB_XGEN(j)  (2304 + 64 * (j))
#define XB_TOP      3328
#define XB_TOPGEN   3392
#define XCD_BAR_WORDS 3456
#define XB_SPIN_CAP (1u << 18)

__device__ __forceinline__ unsigned xb_ld(unsigned* p)              { return __hip_atomic_load(p, __ATOMIC_RELAXED, __HIP_MEMORY_SCOPE_AGENT); }
__device__ __forceinline__ unsigned xb_add(unsigned* p, unsigned v) { return __hip_atomic_fetch_add(p, v, __ATOMIC_RELAXED, __HIP_MEMORY_SCOPE_AGENT); }
__device__ __forceinline__ unsigned xb_xcc_id() { return (unsigned)__builtin_amdgcn_s_getreg((3 << 11) | 20) & 0xFu; }
#define XB_SPIN(cond, bar) do { unsigned _sp = 0; while (cond) { __builtin_amdgcn_s_sleep(1); \
    if ((++_sp & 255u) == 0u) { if (xb_ld(&(bar)[XB_TMO])) break; if (_sp > XB_SPIN_CAP) { atomicAdd(&(bar)[XB_TMO], 1u); break; } } } } while (0)

struct XcdBarrier {
    unsigned* bar; unsigned x; unsigned G;
    volatile LAS unsigned* st;
};

__device__ __forceinline__ XcdBarrier xcd_barrier_post(unsigned* bar, volatile LAS unsigned* st) {
    XcdBarrier b; b.bar = bar; b.x = xb_xcc_id(); b.st = st;
    if (threadIdx.x == 0) (void)xb_add(&bar[XB_XCNT(b.x)], 1u);
    return b;
}
__device__ __forceinline__ void xcd_barrier_complete(unsigned* bar, unsigned x, unsigned& nloc, unsigned& nx, unsigned xb_grid) {
    const unsigned G = xb_grid;
    unsigned sum, cnt, mine, sp = 0u;
    for (;;) {
        sum = 0u; cnt = 0u; mine = 0u;
#pragma unroll
        for (unsigned j = 0; j < 16; ++j) { const unsigned c = xb_ld(&bar[XB_XCNT(j)]); sum += c; cnt += (c > 0u) ? 1u : 0u; mine = (j == x) ? c : mine; }
        if (sum == G) break;
        __builtin_amdgcn_s_sleep(1);
        if ((++sp & 255u) == 0u) { if (xb_ld(&bar[XB_TMO])) break; if (sp > XB_SPIN_CAP) { atomicAdd(&bar[XB_TMO], 1u); break; } }
    }
    nloc = mine > 0u ? mine : 1u; nx = cnt > 0u ? cnt : 1u;
}

__device__ __forceinline__ void xcd_barrier(const XcdBarrier& b) {
    asm volatile("s_waitcnt vmcnt(0)" ::: "memory");
    __syncthreads();
    if (threadIdx.x == 0) {
        unsigned* bar = b.bar;
        __builtin_amdgcn_s_waitcnt(0);
        unsigned nloc = b.st[0], nx = b.st[1];
        if (nloc == 0u) { xcd_barrier_complete(bar, b.x, nloc, nx, b.G); b.st[0] = nloc; b.st[1] = nx; }
        const unsigned old = xb_add(&bar[XB_XSUB(b.x)], 1u);
        const unsigned gen = old / nloc;
        if (old + 1u == (gen + 1u) * nloc) {
            __builtin_amdgcn_fence(__ATOMIC_RELEASE, "agent");
            asm volatile("s_waitcnt vmcnt(0)" ::: "memory");
            const unsigned og = xb_add(&bar[XB_TOP], 1u);
            const unsigned tg = og / nx;
            if (og + 1u == (tg + 1u) * nx) xb_add(&bar[XB_TOPGEN], 1u);
            else XB_SPIN(xb_ld(&bar[XB_TOPGEN]) == tg, bar);
            __builtin_amdgcn_fence(__ATOMIC_ACQUIRE, "agent");
            xb_add(&bar[XB_XGEN(b.x)], 1u);
            asm volatile("s_waitcnt vmcnt(0)" ::: "memory");
        } else {
            XB_SPIN(xb_ld(&bar[XB_XGEN(b.x)]) == gen, bar);
            __builtin_amdgcn_fence(__ATOMIC_ACQUIRE, "agent");
            asm volatile("s_waitcnt vmcnt(0)" ::: "memory");
        }
    }
    __syncthreads();
}

struct Frame {
    LAS unsigned char* lds;
    volatile LAS unsigned* MISC;
    gu32* ctl;
    int tid, lane, wave, vcu, G;
};

__device__ __forceinline__ unsigned pk4_fp8(float a, float b, float c, float d) { int v = 0; v = __builtin_amdgcn_cvt_pk_fp8_f32(a, b, v, false); v = __builtin_amdgcn_cvt_pk_fp8_f32(c, d, v, true); return (unsigned)v; }
template <bool F8>
__device__ __forceinline__ void p0_transpose_item(const float* __restrict__ W, int ldw, const float* __restrict__ gk, float scale, void* __restrict__ WTv, int ldt, int koff, int k0, int n0, int srccol4, LAS float* scr, int lane) {
    const int nq = lane & 15, kr = lane >> 4;
    f32x4 v[16];
#pragma unroll
    for (int i = 0; i < 16; ++i) { v[i] = (f32x4){0.f, 0.f, 0.f, 0.f}; if (srccol4 >= 0) v[i] = __builtin_nontemporal_load((const GAS f32x4*)(W + (size_t)(k0 + 4 * i + kr) * ldw + srccol4)); }
#pragma unroll
    for (int i = 0; i < 16; ++i) v[i] = v[i] * (gk ? gk[k0 + 4 * i + kr] * scale : scale);
#pragma unroll
    for (int i = 0; i < 16; ++i) *(LAS f32x4*)(scr + (4 * i + kr) * 68 + 4 * nq) = v[i];
    LDS_WAIT(); asm volatile("" ::: "memory");
    if constexpr (!F8) { bf16* WT = (bf16*)WTv; const int c = lane & 7;
#pragma unroll
        for (int j = 0; j < 8; ++j) { const int n = (lane >> 3) + 8 * j; const LAS float* s = scr + (8 * c) * 68 + n;
            v4u o; o.x = pk2(s[0 * 68], s[1 * 68]); o.y = pk2(s[2 * 68], s[3 * 68]); o.z = pk2(s[4 * 68], s[5 * 68]); o.w = pk2(s[6 * 68], s[7 * 68]);
            __builtin_nontemporal_store(o, (GAS v4u*)(WT + (size_t)(n0 + n) * ldt + koff + k0 + 8 * c)); }
    } else { unsigned char* WT = (unsigned char*)WTv; const int c = lane & 3;
#pragma unroll
        for (int j = 0; j < 4; ++j) { const int n = (lane >> 2) + 16 * j; const LAS float* s = scr + (16 * c) * 68 + n;
            v4u o; o.x = pk4_fp8(s[0 * 68], s[1 * 68], s[2 * 68], s[3 * 68]); o.y = pk4_fp8(s[4 * 68], s[5 * 68], s[6 * 68], s[7 * 68]); o.z = pk4_fp8(s[8 * 68], s[9 * 68], s[10 * 68], s[11 * 68]); o.w = pk4_fp8(s[12 * 68], s[13 * 68], s[14 * 68], s[15 * 68]);
            __builtin_nontemporal_store(o, (GAS v4u*)(WT + (size_t)(n0 + n) * ldt + koff + k0 + 16 * c)); }
    }
    LDS_WAIT(); asm volatile("" ::: "memory");
}
__device__ __forceinline__ int w1_srccol(int n) {
    if (n < 8704) return n;
    if (n < N1) { const int c = n - 8704; if (c < 32) return 8704 + c; if (c < 48) return 8768 + (c - 32); if (c >= 128 && c < 160) return 8704 + 32 + (c - 128); return -1; }
    { const int c = n - N1; return 8784 + ((c >> 7) & 1) * 2048 + (c >> 8) * 128 + (c & 127); }
}
struct P0Args { const float *x, *g_mix, *w_in, *w_pa, *w_pb, *w_out, *g_mlp, *w_up, *w_dn; unsigned char *W1Q8, *W1G8; bf16* W1I; unsigned char *WP8, *WO8; bf16 *WUt, *WDt, *XB; unsigned char* X8; float* rstd0; };
template <bool DEFERRED>
__device__ __forceinline__ void p0_prologue(Frame& F, const P0Args& A) {
    LAS float* scr = (LAS float*)(F.lds + F.wave * 17408);
    const int gw = F.vcu * NWAVES + F.wave, NGW = F.G * NWAVES;
    constexpr int I_E = (DM / 64) * (N1 / 64), I_G = (DM / 64) * (NG / 64), I_PA = (512 / 64) * (DM / 64), I_PB = (1024 / 64) * (DM / 64), I_O = (DM / 64) * (DM / 64), I_U = (DM / 64) * (DFF / 64), I_D = (DFF / 64) * (DM / 64);
    constexpr int NITEMS = DEFERRED ? I_G + I_PA + I_PB + I_O + I_U + I_D : I_E;
    const int nq4 = 4 * (F.lane & 15);
    for (int it = gw; it < NITEMS; it += NGW) {
        int r = it;
        if constexpr (!DEFERRED) { const int nb = N1 / 64, kb = r / nb, n0 = 64 * (r % nb); const int sc4 = w1_srccol(n0 + nq4);
            if (n0 < NQKV_W) p0_transpose_item<true>(A.w_in, D_IN, A.g_mix, W8_SCALE, A.W1Q8, DM, 0, 64 * kb, n0, sc4, scr, F.lane);
            else p0_transpose_item<false>(A.w_in, D_IN, A.g_mix, 1.f, A.W1I, DM, 0, 64 * kb, n0 - NQKV_W, sc4, scr, F.lane);
        } else {
        if (r < I_G) { const int nb = NG / 64, kb = r / nb, n0 = 64 * (r % nb); p0_transpose_item<true>(A.w_in, D_IN, A.g_mix, W8_SCALE, A.W1G8, DM, 0, 64 * kb, n0, w1_srccol(N1 + n0 + nq4), scr, F.lane); continue; } r -= I_G;
        if (r < I_PA) { const int nb = DM / 64, kb = r / nb, n0 = 64 * (r % nb); p0_transpose_item<true>(A.w_pa, DM, nullptr, WP8_SCALE, A.WP8, KP, 0, 64 * kb, n0, n0 + nq4, scr, F.lane); continue; } r -= I_PA;
        if (r < I_PB) { const int nb = DM / 64, kb = r / nb, n0 = 64 * (r % nb); p0_transpose_item<true>(A.w_pb, DM, nullptr, WP8_SCALE, A.WP8, KP, 512, 64 * kb, n0, n0 + nq4, scr, F.lane); continue; } r -= I_PB;
        if (r < I_O) { const int nb = DM / 64, kb = r / nb, n0 = 64 * (r % nb); p0_transpose_item<true>(A.w_out, DM, nullptr, W8_SCALE, A.WO8, DM, 0, 64 * kb, n0, n0 + nq4, scr, F.lane); continue; } r -= I_O;
        if (r < I_U) { const int nb = DFF / 64, kb = r / nb, n0 = 64 * (r % nb); p0_transpose_item<false>(A.w_up, DFF, A.g_mlp, 1.f, A.WUt, DM, 0, 64 * kb, n0, n0 + nq4, scr, F.lane); continue; } r -= I_U;
        { const int nb = DM / 64, kb = r / nb, n0 = 64 * (r % nb); p0_transpose_item<false>(A.w_dn, DM, nullptr, 1.f, A.WDt, DFF, 0, 64 * kb, n0, n0 + nq4, scr, F.lane); }
        }
    }
    if constexpr (DEFERRED) return;
    for (int m = gw; m < M; m += NGW) {
        const GAS f32x4* xr = (const GAS f32x4*)(A.x + (size_t)m * DM) + F.lane; f32x4 v[8]; float s = 0.f;
#pragma unroll
        for (int j = 0; j < 8; ++j) { v[j] = __builtin_nontemporal_load(xr + 64 * j); s += (v[j].x * v[j].x + v[j].y * v[j].y) + (v[j].z * v[j].z + v[j].w * v[j].w); }
        s = wave_sum(s);
        GAS unsigned long long* o8 = (GAS unsigned long long*)(A.XB + (size_t)m * DM) + F.lane; GAS unsigned* o4 = (GAS unsigned*)(A.X8 + (size_t)m * DM) + F.lane;
#pragma unroll
        for (int j = 0; j < 8; ++j) { o8[64 * j] = (unsigned long long)pk2(v[j].x, v[j].y) | ((unsigned long long)pk2(v[j].z, v[j].w) << 32); o4[64 * j] = pk4_fp8(v[j].x, v[j].y, v[j].z, v[j].w); }
        if (F.lane == 0) A.rstd0[m] = 1.0f / sqrtf(s * (1.0f / DM) + 1e-6f);
    }
}

__device__ __forceinline__ int half32_sum_i(int v, int hi) {
    v += __builtin_amdgcn_update_dpp(0, v, 0xB1, 0xF, 0xF, true);
    v += __builtin_amdgcn_update_dpp(0, v, 0x4E, 0xF, 0xF, true);
    v += __builtin_amdgcn_update_dpp(0, v, 0x141, 0xF, 0xF, true);
    v += __builtin_amdgcn_update_dpp(0, v, 0x140, 0xF, 0xF, true);
    const int t0 = __builtin_amdgcn_readlane(v, 0) + __builtin_amdgcn_readlane(v, 16), t1 = __builtin_amdgcn_readlane(v, 32) + __builtin_amdgcn_readlane(v, 48);
    return hi ? t1 : t0;
}
__device__ __forceinline__ float relu_i(float x) { const int b = __float_as_int(x); return __int_as_float(b > 0 ? b : 0); }
__device__ __forceinline__ void index_unit(const bf16* __restrict__ QI, const bf16* __restrict__ KI, const float* __restrict__ WI, unsigned* __restrict__ MASK, int b, int t0, int lane) {
    const int rho = lane & 31, hi = lane >> 5;
    const size_t tb = (size_t)b * SEQ;
    bf16x8 a[4];
    { const bf16* ap = QI + (tb + t0 + ((rho >> 2) & 1)) * 1024 + ((rho & 3) + 4 * (rho >> 3)) * 64 + 8 * hi;
#pragma unroll
      for (int ks = 0; ks < 4; ++ks) a[ks] = *(const bf16x8*)(ap + 16 * ks); }
    float w[16];
    { const f32x4* wp = (const f32x4*)(WI + (tb + t0 + hi) * 16);
#pragma unroll
      for (int i = 0; i < 4; ++i) { const f32x4 v = wp[i]; w[4 * i] = v[0]; w[4 * i + 1] = v[1]; w[4 * i + 2] = v[2]; w[4 * i + 3] = v[3]; } }
    const int nkb = (t0 + 1) / 32 + 1;
    const bf16* kbase = KI + (tb >> 5) * 2048;
    unsigned kloff = (unsigned)lane * 8u; asm volatile("" : "+v"(kloff));
    const int tq = t0 + hi;
    float sc[64];
    bf16x8 bq[2][2][4];
    const int np = (nkb + 1) >> 1;
#define IDX_LOADP(slot, pp_) do { const bf16* kp_ = kbase + (size_t)(pp_) * 4096; _Pragma("unroll") for (int e = 0; e < 2; ++e) _Pragma("unroll") for (int ks = 0; ks < 4; ++ks) bq[slot][e][ks] = *(const bf16x8*)(kp_ + 2048 * e + 512 * ks + kloff); } while (0)
    IDX_LOADP(0, 0);
#pragma unroll
    for (int pp = 0; pp < 32; ++pp) {
        sc[2 * pp] = -FLT_MAX; sc[2 * pp + 1] = -FLT_MAX;
        if (pp < np) {
            if (pp + 1 < np) IDX_LOADP((pp + 1) & 1, pp + 1);
            f32x16 c0 = {}, c1 = {};
#pragma unroll
            for (int ks = 0; ks < 4; ++ks) { c0 = __builtin_amdgcn_mfma_f32_32x32x16_bf16(a[ks], bq[pp & 1][0][ks], c0, 0, 0, 0); c1 = __builtin_amdgcn_mfma_f32_32x32x16_bf16(a[ks], bq[pp & 1][1][ks], c1, 0, 0, 0); }
            float s0, s1;
            { typedef float f32x2 __attribute__((ext_vector_type(2)));
              f32x2 p0a = {0.f, 0.f}, p0b = {0.f, 0.f}, p1a = {0.f, 0.f}, p1b = {0.f, 0.f};
#define RELU_I(x) relu_i(x)
#pragma unroll
              for (int r = 0; r < 16; r += 4) { const f32x2 wa = {w[r], w[r + 1]}, wb = {w[r + 2], w[r + 3]};
                  p0a = __builtin_elementwise_fma((f32x2){RELU_I(c0[r]), RELU_I(c0[r + 1])}, wa, p0a); p0b = __builtin_elementwise_fma((f32x2){RELU_I(c0[r + 2]), RELU_I(c0[r + 3])}, wb, p0b);
                  p1a = __builtin_elementwise_fma((f32x2){RELU_I(c1[r]), RELU_I(c1[r + 1])}, wa, p1a); p1b = __builtin_elementwise_fma((f32x2){RELU_I(c1[r + 2]), RELU_I(c1[r + 3])}, wb, p1b); }
#undef RELU_I
              s0 = (p0a[0] + p0a[1]) + (p0b[0] + p0b[1]); s1 = (p1a[0] + p1a[1]) + (p1b[0] + p1b[1]); }
            sc[2 * pp] = (pp * 64 + rho <= tq) ? s0 : -FLT_MAX; sc[2 * pp + 1] = (pp * 64 + 32 + rho <= tq) ? s1 : -FLT_MAX;
        }
    }
#undef IDX_LOADP
    float mx, mn;
    { float mxp[4] = {-FLT_MAX, -FLT_MAX, -FLT_MAX, -FLT_MAX}, mnp[4] = {FLT_MAX, FLT_MAX, FLT_MAX, FLT_MAX};
#pragma unroll
      for (int q = 0; q < 8; ++q) if (8 * q < nkb) {
#pragma unroll
          for (int kb = 8 * q; kb < 8 * q + 8; ++kb) { const float v = sc[kb]; mxp[kb & 3] = fmaxf(mxp[kb & 3], v); mnp[kb & 3] = (v > -FLT_MAX) ? fminf(mnp[kb & 3], v) : mnp[kb & 3]; } }
      mx = fmaxf(fmaxf(mxp[0], mxp[1]), fmaxf(mxp[2], mxp[3])); mn = fminf(fminf(mnp[0], mnp[1]), fminf(mnp[2], mnp[3])); }
#pragma unroll
    for (int o = 1; o < 32; o <<= 1) { mx = fmaxf(mx, __shfl_xor(mx, o)); mn = fminf(mn, __shfl_xor(mn, o)); }
    float lo = mn, hb = mx, thr = mn; bool done = (tq + 1 <= 256);
    if (done) thr = -3.0e38f;
    float flo = (float)(tq + 1) - 256.5f, fhb = 1.0f - 256.5f; int side = 0;
    for (int it = 0; it < 96; ++it) {
        if (__all(done)) break;
        float tfr = flo * __builtin_amdgcn_rcpf(flo - fhb);
        tfr = fminf(fmaxf(tfr, 0.02f), 0.98f);
        const float mid = lo + (hb - lo) * tfr;
        const bool stuck = !(mid > lo) || !(mid < hb);
        int cn = 0;
#pragma unroll
        for (int q = 0; q < 8; ++q) if (8 * q < nkb) {
#pragma unroll
            for (int kb = 8 * q; kb < 8 * q + 8; ++kb) cn += (sc[kb] >= mid) ? 1 : 0; }
        const int c = half32_sum_i(cn, hi);
        if (!done) {
            if (stuck) { thr = lo; done = true; }
            else if (c == 256) { thr = mid; done = true; }
            else if (c > 256) { lo = mid; flo = (float)c - 256.5f; if (side > 0) fhb *= 0.5f; side = 1; } else { hb = mid; fhb = (float)c - 256.5f; if (side < 0) flo *= 0.5f; side = -1; }
        }
    }
    if (!done) thr = lo;
    unsigned w0 = 0u, w1 = 0u;
    int lane_o = lane;
#pragma unroll
    for (int q = 0; q < 8; ++q) if (8 * q < nkb) {
#pragma unroll
      for (int kb = 8 * q; kb < 8 * q + 8; ++kb) { const unsigned long long bal = __ballot(sc[kb] >= thr); const unsigned blo = (unsigned)bal, bhi = (unsigned)(bal >> 32);
        w0 = (lane_o == kb) ? blo : w0; w1 = (lane_o == kb) ? bhi : w1;
        asm volatile("" : "+v"(w0), "+v"(w1), "+v"(lane_o)); } }
    MASK[(tb + t0) * 64 + lane] = w0; MASK[(tb + t0 + 1) * 64 + lane] = w1;
}

#define KSWZ(row, colB) ((row) * 256 + ((colB) ^ (((row) & 7) << 4)))
__device__ __forceinline__ int v_st(int k, int c) { const int kk = (k & ~0xC) | ((k & 4) << 1) | ((k & 8) >> 1); return ((kk >> 3) * 4 + (c >> 5)) * 512 + ((kk & 7) * 32 + (c & 31)) * 2; }
__device__ __forceinline__ int v_rd_base(int lane) { return ((lane & 3) << 3) | (((lane >> 2) & 3) << 6) | (((lane >> 4) & 1) << 5) | (((lane >> 5) & 1) << 8); }
constexpr int v_rd_off(int d0, int ks, int half) { return d0 * 512 + ks * 4096 + half * 2048; }
template <int OFF> __device__ __forceinline__ s16x4 tr_read(int vb) { s16x4 r; asm volatile("ds_read_b64_tr_b16 %0, %1 offset:%2" : "=&v"(r) : "v"(vb), "i"(OFF) : "memory"); return r; }
#define PKV(L, H) (bf16x8){L[0], L[1], L[2], L[3], H[0], H[1], H[2], H[3]}
#define PK4(P, BASE, OUT) do { unsigned a0_ = cvtpk(P[BASE + 0], P[BASE + 1]), a1_ = cvtpk(P[BASE + 2], P[BASE + 3]);   \
    unsigned b0_ = cvtpk(P[BASE + 4], P[BASE + 5]), b1_ = cvtpk(P[BASE + 6], P[BASE + 7]);                              \
    auto r0_ = __builtin_amdgcn_permlane32_swap(a0_, b0_, false, false); auto r1_ = __builtin_amdgcn_permlane32_swap(a1_, b1_, false, false); \
    v4u w_ = {r0_[0], r1_[0], r0_[1], r1_[1]}; OUT = __builtin_bit_cast(bf16x8, w_); } while (0)
__device__ __forceinline__ float half_max(float v) { auto rr = __builtin_amdgcn_permlane32_swap(__float_as_uint(v), __float_as_uint(v), false, false); return fmaxf(__uint_as_float(rr[0]), __uint_as_float(rr[1])); }
__device__ __forceinline__ float half_sum(float v) { auto rr = __builtin_amdgcn_permlane32_swap(__float_as_uint(v), __float_as_uint(v), false, false); return __uint_as_float(rr[0]) + __uint_as_float(rr[1]); }
__device__ __forceinline__ int lds_addr(const LAS void* p) { return (int)(unsigned)(uintptr_t)p; }

constexpr int WL_V = 0, WL_Q = 8192, WL_X = 16384, WL_BYTES = 16384 + 512;
constexpr int TABA_N = 192, TABB_N = 2112;
template <int MODE> struct WUnit {
    const bf16* qp; const bf16* kp; const bf16* vp;
    int dsh, r, p0; const LAS float* tab; const unsigned* mrow;
    LAS unsigned char* wl; int lane;
};
template <int MODE>
__device__ __forceinline__ void wu_block(const WUnit<MODE>& U, bf16x8 (&kc)[8], bf16x8 (&vs)[8], unsigned& mwr, bool has_next, int ps, int pn  , f32x16 (&o)[4], float& m_run, float& l_run) {
    const int q = U.lane & 31, hi = U.lane >> 5, vkey0 = U.lane >> 4, vcol = (U.lane & 15) * 8;
    const unsigned mw = mwr; (void)mw;
    static_assert(MODE == 0, "wu_block: the dilated-window path only (the bitmask path was replaced by the dense mixer-B body)");
    const int jb = U.p0 - ps + q - 4 * hi;
    const LAS float* tq_ = U.tab + (TABA_N - 1 - 32) - jb;
    const float mref = (m_run == NEGV) ? 0.f : m_run;
    f32x16 p, p2 = {};
#pragma unroll
    for (int rr = 0; rr < 16; ++rr) { const int cr = (rr & 3) + 8 * (rr >> 2); p[rr] = tq_[cr] - mref; }
#pragma unroll
    for (int d0 = 0; d0 < 8; d0 += 2) { p = __builtin_amdgcn_mfma_f32_32x32x16_bf16(kc[d0], *(const LAS bf16x8*)(U.wl + WL_Q + U.lane * 16 + d0 * 1024), p, 0, 0, 0);
        p2 = __builtin_amdgcn_mfma_f32_32x32x16_bf16(kc[d0 + 1], *(const LAS bf16x8*)(U.wl + WL_Q + U.lane * 16 + (d0 + 1) * 1024), p2, 0, 0, 0); }
    if (has_next) {
        const bf16* kp = U.kp + (size_t)(pn >> 5) * 4096 + U.lane * 8;
#pragma unroll
        for (int d0 = 0; d0 < 8; ++d0) kc[d0] = *(const bf16x8*)(kp + 512 * d0);
    }
    float pmax;
    { float pm4[4] = {NEGV, NEGV, NEGV, NEGV};
#pragma unroll
      for (int rr = 0; rr < 16; ++rr) { p[rr] += p2[rr]; pm4[rr & 3] = fmaxf(pm4[rr & 3], p[rr]); }
      pmax = fmaxf(fmaxf(pm4[0], pm4[1]), fmaxf(pm4[2], pm4[3])); }
    pmax = half_max(pmax);
    const bool started = (m_run != NEGV), live = pmax > 0.5f * NEGV;
    float alpha = 1.f;
    if (__builtin_expect(__any(started ? (pmax > 8.0f * LOG2E) : live), 0)) {
        const float delta = started ? fmaxf(pmax, 0.f) : (live ? pmax : 0.f);
        alpha = started ? __builtin_amdgcn_exp2f(-delta) : (live ? 0.f : 1.f);
        m_run = started ? m_run + delta : (live ? delta : NEGV);
#pragma unroll
        for (int rr = 0; rr < 16; ++rr) p[rr] -= delta; }
    float psum;
    { float ps4[4] = {0.f, 0.f, 0.f, 0.f};
#pragma unroll
      for (int rr = 0; rr < 16; ++rr) { p[rr] = __builtin_amdgcn_exp2f(p[rr]); ps4[rr & 3] += p[rr]; }
      psum = (ps4[0] + ps4[1]) + (ps4[2] + ps4[3]); }
    psum = half_sum(psum); l_run = l_run * alpha + psum;
    LAS float* al_l = (LAS float*)(U.wl + WL_X);
    if (__any(alpha < 1.f)) {
        if (hi == 0) al_l[q] = alpha;
        LDS_WAIT();
#pragma unroll
        for (int rr = 0; rr < 16; ++rr) { const float a = al_l[crow(rr, hi)];
#pragma unroll
            for (int d = 0; d < 4; ++d) o[d][rr] *= a; }
    }
    bf16x8 pa0, pa1; PK4(p, 0, pa0); PK4(p, 8, pa1);
#pragma unroll
    for (int i = 0; i < 8; ++i) *(LAS bf16x8*)(U.wl + WL_V + v_st(vkey0 + 4 * i, vcol)) = vs[i];
    if (has_next) {
        unsigned voff = (unsigned)(((vkey0 << U.dsh) + U.r) * NQKV + vcol); asm volatile("" : "+v"(voff));
        const bf16* vrow = U.vp + (size_t)(pn << U.dsh) * NQKV;
#pragma unroll
        for (int i = 0; i < 8; ++i) vs[i] = *(const bf16x8*)(vrow + (size_t)((4 * i) << U.dsh) * NQKV + voff);
    }
    asm volatile("" ::: "memory");
    const int vb = lds_addr(U.wl + WL_V) + v_rd_base(U.lane);
#define PVR(D0, l0, h0, l1, h1) const s16x4 l0 = tr_read<v_rd_off(D0, 0, 0)>(vb), h0 = tr_read<v_rd_off(D0, 0, 1)>(vb), l1 = tr_read<v_rd_off(D0, 1, 0)>(vb), h1 = tr_read<v_rd_off(D0, 1, 1)>(vb)
#define PVM(D0, l0, h0, l1, h1) do { o[D0] = __builtin_amdgcn_mfma_f32_32x32x16_bf16(pa0, PKV(l0, h0), o[D0], 0, 0, 0); o[D0] = __builtin_amdgcn_mfma_f32_32x32x16_bf16(pa1, PKV(l1, h1), o[D0], 0, 0, 0); } while (0)
    PVR(0, a0l, a0h, a1l, a1h); PVR(1, b0l, b0h, b1l, b1h);
    asm volatile("s_waitcnt lgkmcnt(0)" ::: "memory"); SBAR();
    PVR(2, c0l, c0h, c1l, c1h); PVR(3, d0l, d0h, d1l, d1h);
    PVM(0, a0l, a0h, a1l, a1h); PVM(1, b0l, b0h, b1l, b1h);
    asm volatile("s_waitcnt lgkmcnt(0)" ::: "memory"); SBAR();
    PVM(2, c0l, c0h, c1l, c1h); PVM(3, d0l, d0h, d1l, d1h);
#undef PVR
#undef PVM
}
template <int MODE>
__device__ __forceinline__ void wu_run(const WUnit<MODE>& U, int ps_begin, bool desc  , bf16* __restrict__ Ob, int ldo, float* __restrict__ lse) {
    const int q = U.lane & 31, hi = U.lane >> 5, vkey0 = U.lane >> 4, vcol = (U.lane & 15) * 8;
    { const bf16* qp = U.qp + (size_t)(((U.p0 + q) << U.dsh) + U.r) * NQKV + 8 * hi;
#pragma unroll
      for (int d0 = 0; d0 < 8; ++d0) *(LAS bf16x8*)(U.wl + WL_Q + U.lane * 16 + d0 * 1024) = *(const bf16x8*)(qp + 16 * d0); }
    f32x16 o[4] = {}; float m_run = NEGV, l_run = 0.f;
    bf16x8 kc[8], vs[8]; unsigned mw = 0u;
    { unsigned voff = (unsigned)(((vkey0 << U.dsh) + U.r) * NQKV + vcol); asm volatile("" : "+v"(voff));
      const bf16* vrow = U.vp + (size_t)((desc ? U.p0 : ps_begin) << U.dsh) * NQKV;
#pragma unroll
      for (int i = 0; i < 8; ++i) vs[i] = *(const bf16x8*)(vrow + (size_t)((4 * i) << U.dsh) * NQKV + voff); }
    const int ps0 = desc ? U.p0 : ps_begin, step = desc ? -32 : 32, nblk = ((U.p0 - ps_begin) >> 5) + 1;
    { const bf16* kp = U.kp + (size_t)(ps0 >> 5) * 4096 + U.lane * 8;
#pragma unroll
      for (int d0 = 0; d0 < 8; ++d0) kc[d0] = *(const bf16x8*)(kp + 512 * d0);
      if (MODE == 1) mw = U.mrow[ps0 >> 5]; }
#pragma unroll 1
    for (int k = 0, ps = ps0; k < nblk; ++k, ps += step) wu_block<MODE>(U, kc, vs, mw, k + 1 < nblk, ps, ps + step, o, m_run, l_run);
    LAS float* li_l = (LAS float*)(U.wl + WL_X) + 32;
    if (hi == 0) li_l[q] = l_run;
    LDS_WAIT();
    if (MODE == 0) {
#pragma unroll
        for (int rr = 0; rr < 16; ++rr) { const float rl = __builtin_amdgcn_rcpf(li_l[crow(rr, hi)]); LAS bf16* rowp = (LAS bf16*)(U.wl + WL_V + crow(rr, hi) * 256) + q;
#pragma unroll
            for (int d = 0; d < 4; ++d) rowp[32 * d] = (bf16)f2bf(o[d][rr] * rl); }
        LDS_WAIT();
        unsigned ooff = (unsigned)(((vkey0 << U.dsh) + U.r) * ldo + vcol); asm volatile("" : "+v"(ooff));
        bf16* orow = Ob + (size_t)(U.p0 << U.dsh) * ldo;
#pragma unroll
        for (int i = 0; i < 8; ++i) { const bf16x8 v = *(const LAS bf16x8*)(U.wl + WL_V + (vkey0 + 4 * i) * 256 + vcol * 2);
            *(bf16x8*)(orow + (size_t)((4 * i) << U.dsh) * ldo + ooff) = v; }
    } else {
#pragma unroll
        for (int rr = 0; rr < 16; ++rr) { const float rl = __builtin_amdgcn_rcpf(li_l[crow(rr, hi)]) * O8_SCALE; LAS unsigned char* rowp = U.wl + WL_V + crow(rr, hi) * 128 + q;
#pragma unroll
            for (int d = 0; d < 4; ++d) { const float x = o[d][rr] * rl; rowp[32 * d] = (unsigned char)__builtin_amdgcn_cvt_pk_fp8_f32(x, x, 0, false); } }
        LDS_WAIT();
        unsigned ooff = (unsigned)((U.lane >> 3) * ldo + (U.lane & 7) * 16); asm volatile("" : "+v"(ooff));
        unsigned char* orow = (unsigned char*)Ob + (size_t)U.p0 * ldo;
#pragma unroll
        for (int i = 0; i < 4; ++i) { const v4u v = *(const LAS v4u*)(U.wl + WL_V + ((U.lane >> 3) + 8 * i) * 128 + (U.lane & 7) * 16);
            *(v4u*)(orow + (size_t)(8 * i) * ldo + ooff) = v; }
    }
    if (MODE == 0) { if (hi == 0) lse[(size_t)(((U.p0 + q) << U.dsh) + U.r) * 4] = m_run + __builtin_amdgcn_logf(l_run); }
    LDS_WAIT();
}

namespace ab {
constexpr int D = 128, KVBLK = 64, LDQ = NQKV, LDK = NQKV, LDO = KP;
constexpr int SHM_V = KVBLK * D * 2, SHM_K = KVBLK * D * 2, SHM_ATTN = 2 * SHM_V + 2 * SHM_K + NWAVES * 64 * 4;
constexpr int GUARD = 260, TABD_N = GUARD + 2048, TABB_OFF = SHM_ATTN;
constexpr int QS_OFF = 77824, QS_WAVE = 8192;
constexpr float THR2 = 8.0f * LOG2E;
#ifndef AB_SDEPTH
#define AB_SDEPTH 1
#endif
constexpr int SDEPTH = AB_SDEPTH;
__device__ __forceinline__ void initSM(f32x16& p0, f32x16& p1, float m_reg, const LAS float* tp) {
    const float mref = (m_reg == NEGV) ? 0.f : m_reg;
#pragma unroll
    for (int r = 0; r < 16; ++r) { const int cr = (r & 3) + 8 * (r >> 2); p0[r] = tp[cr] - mref; }
    SBAR();
#pragma unroll
    for (int r = 0; r < 16; ++r) { const int cr = (r & 3) + 8 * (r >> 2); p1[r] = tp[32 + cr] - mref; }
}
__device__ __forceinline__ float msel(unsigned m, int bit, float x) {
    const unsigned k = (unsigned)__builtin_amdgcn_sbfe((int)m, (unsigned)bit, 1u); return __uint_as_float(__builtin_amdgcn_bitop3_b32(k, __float_as_uint(x), __float_as_uint(NEGV), 0xCA));
}
__device__ __forceinline__ void partialSM(f32x16& p0, f32x16& p1, float& m_reg, float& alpha, unsigned mlo, unsigned mhi) {
#pragma unroll
    for (int r = 0; r < 16; ++r) { const int cr = (r & 3) + 8 * (r >> 2); p0[r] = msel(mlo, cr, p0[r]); p1[r] = msel(mhi, cr, p1[r]); }
    float pmax;
    { float pm4[4] = {p0[0], p0[1], p0[2], p0[3]};
#pragma unroll
      for (int r = 4; r < 16; ++r) pm4[r & 3] = fmaxf(pm4[r & 3], p0[r]);
#pragma unroll
      for (int r = 0; r < 16; ++r) pm4[r & 3] = fmaxf(pm4[r & 3], p1[r]);
      pmax = fmaxf(fmaxf(pm4[0], pm4[1]), fmaxf(pm4[2], pm4[3])); }
    pmax = half_max(pmax);
    const bool started = (m_reg != NEGV), live = pmax > 0.5f * NEGV;
    if (__builtin_expect(!__any(started ? (pmax > THR2) : live), 1)) { alpha = 1.f; }
    else { const float delta = started ? fmaxf(pmax, 0.f) : (live ? pmax : 0.f);
        alpha = started ? __builtin_amdgcn_exp2f(-delta) : (live ? 0.f : 1.f);
        m_reg = started ? m_reg + delta : (live ? delta : NEGV);
#pragma unroll
        for (int r = 0; r < 16; ++r) { p0[r] -= delta; p1[r] -= delta; } }
#pragma unroll
    for (int r = 0; r < 16; ++r) p0[r] = __builtin_amdgcn_exp2f(p0[r]);
}
__device__ __forceinline__ void finishSM(f32x16& p0, f32x16& p1, float alpha, float& l_reg, bf16x8& pa0, bf16x8& pa1, bf16x8& pa2, bf16x8& pa3) {
#pragma unroll
    for (int r = 0; r < 16; ++r) p1[r] = __builtin_amdgcn_exp2f(p1[r]);
    float ps;
    { float ps4[4] = {0.f, 0.f, 0.f, 0.f};
#pragma unroll
      for (int r = 0; r < 16; ++r) ps4[r & 3] += p0[r];
#pragma unroll
      for (int r = 0; r < 16; ++r) ps4[r & 3] += p1[r];
      ps = (ps4[0] + ps4[1]) + (ps4[2] + ps4[3]); }
    ps = half_sum(ps);
    l_reg = l_reg * alpha + ps;
    PK4(p0, 0, pa0); PK4(p0, 8, pa1); PK4(p1, 0, pa2); PK4(p1, 8, pa3);
}
#ifndef AB_QREG
#define AB_QREG 1
#endif
__device__ __forceinline__ void qkt_r(f32x16& p0, f32x16& p1, const LAS unsigned char* Ks, const bf16x8 (&qf)[8], int r32, int hi) {
#pragma unroll
    for (int d0 = 0; d0 < 8; ++d0) { const int lo_ = (r32 + 32 * hi) * 16;
        const bf16x8 b0 = *(const LAS bf16x8*)(Ks + d0 * 1024 + lo_);
        const bf16x8 b1 = *(const LAS bf16x8*)(Ks + 8192 + d0 * 1024 + lo_);
        p0 = __builtin_amdgcn_mfma_f32_32x32x16_bf16(b0, qf[d0], p0, 0, 0, 0);
        p1 = __builtin_amdgcn_mfma_f32_32x32x16_bf16(b1, qf[d0], p1, 0, 0, 0); }
}
__device__ __forceinline__ void qkt(f32x16& p0, f32x16& p1, const LAS unsigned char* Ks, const LAS unsigned char* qs, int r32, int hi) {
#pragma unroll
    for (int d0 = 0; d0 < 8; ++d0) { const int lo_ = (r32 + 32 * hi) * 16;
        const bf16x8 b0 = *(const LAS bf16x8*)(Ks + d0 * 1024 + lo_);
        const bf16x8 b1 = *(const LAS bf16x8*)(Ks + 8192 + d0 * 1024 + lo_);
        const bf16x8 q = *(const LAS bf16x8*)(qs + d0 * 1024);
        p0 = __builtin_amdgcn_mfma_f32_32x32x16_bf16(b0, q, p0, 0, 0, 0);
        p1 = __builtin_amdgcn_mfma_f32_32x32x16_bf16(b1, q, p1, 0, 0, 0); }
}
template <int D0> __device__ __forceinline__ void pv_one(f32x16& od, int vb, bf16x8 pa0, bf16x8 pa1, bf16x8 pa2, bf16x8 pa3) {
    const s16x4 l0 = tr_read<v_rd_off(D0, 0, 0)>(vb), h0 = tr_read<v_rd_off(D0, 0, 1)>(vb), l1 = tr_read<v_rd_off(D0, 1, 0)>(vb), h1 = tr_read<v_rd_off(D0, 1, 1)>(vb);
    const s16x4 l2 = tr_read<v_rd_off(D0, 2, 0)>(vb), h2 = tr_read<v_rd_off(D0, 2, 1)>(vb), l3 = tr_read<v_rd_off(D0, 3, 0)>(vb), h3 = tr_read<v_rd_off(D0, 3, 1)>(vb);
    asm volatile("s_waitcnt lgkmcnt(0)" ::: "memory"); SBAR();
    od = __builtin_amdgcn_mfma_f32_32x32x16_bf16(pa0, PKV(l0, h0), od, 0, 0, 0);
    od = __builtin_amdgcn_mfma_f32_32x32x16_bf16(pa1, PKV(l1, h1), od, 0, 0, 0);
    od = __builtin_amdgcn_mfma_f32_32x32x16_bf16(pa2, PKV(l2, h2), od, 0, 0, 0);
    od = __builtin_amdgcn_mfma_f32_32x32x16_bf16(pa3, PKV(l3, h3), od, 0, 0, 0);
}
__device__ __forceinline__ void pv_d0(f32x16* o, int vb, bf16x8 pa0, bf16x8 pa1, bf16x8 pa2, bf16x8 pa3) {
    pv_one<0>(o[0], vb, pa0, pa1, pa2, pa3); pv_one<1>(o[1], vb, pa0, pa1, pa2, pa3); pv_one<2>(o[2], vb, pa0, pa1, pa2, pa3); pv_one<3>(o[3], vb, pa0, pa1, pa2, pa3);
}
__device__ __forceinline__ void attnB_block(const bf16* __restrict__ Qb, const bf16* __restrict__ Kh, const bf16* __restrict__ Vh, unsigned char* __restrict__ Ob,
                                            const unsigned* __restrict__ mrow0, int tq0, int NT, LAS unsigned char* lds) {
    const int tid = threadIdx.x, wid = tid >> 6, lane = tid & 63, r32 = lane & 31, hi = lane >> 5;
    LAS unsigned char* V_lds = lds; LAS unsigned char* K_lds = lds + 2 * SHM_V;
    LAS float* ws = (LAS float*)(lds + 2 * SHM_V + 2 * SHM_K) + wid * 64; LAS float* li_l = ws; LAS float* al_l = ws + 32;
    float m_reg = NEGV, l_reg = 0; f32x16 o[4] = {};
    bf16x8 qf[8];
    LAS unsigned char* qr = lds + QS_OFF + wid * QS_WAVE + lane * 16;
    { unsigned qoff = (unsigned)((wid * 32 + r32) * LDQ + hi * 8) * 2u; asm volatile("" : "+v"(qoff));
#pragma unroll
      for (int d0 = 0; d0 < 8; ++d0) { qf[d0] = *(const bf16x8*)((const char*)Qb + qoff + d0 * 32); if (!AB_QREG) *(LAS bf16x8*)(qr + d0 * 1024) = qf[d0]; } }
    const int sr = tid >> 4, sc = (tid & 15) * 8, vst0 = v_st(sr, sc), vst1 = vst0 + 8192;
    const int vb0 = lds_addr(V_lds) + v_rd_base(lane);
    unsigned voffV = (unsigned)(sr * LDK + sc) * 2u, voffK = (unsigned)tid * 16u, voffM = (unsigned)(wid * 32 + r32) * 256u; asm volatile("" : "+v"(voffV), "+v"(voffK), "+v"(voffM));
    const LAS float* tp0 = (const LAS float*)(lds + TABB_OFF) + (TABD_N - 1 - GUARD - (tq0 + wid * 32 + r32) + 4 * hi);
    struct { bf16x8 vs0, vs1, ks0, ks1; unsigned long long mk; } sr_[SDEPTH];
#define SLOAD(i, k0) do { const char* vb_ = (const char*)Vh + (size_t)(k0) * (LDK * 2); const char* kb_ = (const char*)Kh + (size_t)(k0) * 256; \
    sr_[i].vs0 = *(const bf16x8*)(vb_ + voffV); sr_[i].vs1 = *(const bf16x8*)(vb_ + 32 * LDK * 2 + voffV); \
    sr_[i].ks0 = *(const bf16x8*)(kb_ + voffK); sr_[i].ks1 = *(const bf16x8*)(kb_ + 8192 + voffK); sr_[i].mk = *(const unsigned long long*)((const char*)mrow0 + (size_t)((k0) >> 6) * 8 + voffM); } while (0)
#define SWRITE(b, i) do { *(LAS bf16x8*)(V_lds + (b) * SHM_V + vst0) = sr_[i].vs0; *(LAS bf16x8*)(V_lds + (b) * SHM_V + vst1) = sr_[i].vs1; const int kc = sc * 2;  \
    *(LAS bf16x8*)(K_lds + (b) * SHM_K + voffK) = sr_[i].ks0; *(LAS bf16x8*)(K_lds + (b) * SHM_K + 8192 + voffK) = sr_[i].ks1; (void)kc; } while (0)
#define SWAIT() do { if constexpr (SDEPTH == 2) asm volatile("s_waitcnt vmcnt(5)" ::: "memory"); else asm volatile("s_waitcnt vmcnt(0)" ::: "memory"); } while (0)
#define RESC(a) do { if (__any((a) < 1.f)) { if (hi == 0) al_l[r32] = (a); asm volatile("s_waitcnt lgkmcnt(0)" ::: "memory"); \
    _Pragma("unroll") for (int d = 0; d < 4; ++d) _Pragma("unroll") for (int r = 0; r < 16; ++r) o[d][r] *= al_l[crow(r, hi)]; } } while (0)
#define QKT(P0, P1, KS) do { if (AB_QREG) qkt_r(P0, P1, KS, qf, r32, hi); else qkt(P0, P1, KS, qr, r32, hi); } while (0)
#define MLO(m) ((unsigned)(m) >> (4 * hi))
#define MHI(m) ((unsigned)((m) >> 32) >> (4 * hi))
    f32x16 pA0, pA1, pB0, pB1; float alA, alB; bf16x8 pa0, pa1, pa2, pa3; unsigned long long mA, mB;
    constexpr int SE = 0, SO = SDEPTH - 1;
    if (__builtin_amdgcn_readfirstlane(threadIdx.x) >= 256) __builtin_amdgcn_s_setprio(1);
    SLOAD(SE, 0); asm volatile("s_waitcnt vmcnt(0)" ::: "memory"); SWRITE(0, SE); mA = sr_[SE].mk; __syncthreads();
    initSM(pA0, pA1, m_reg, tp0); QKT(pA0, pA1, K_lds); partialSM(pA0, pA1, m_reg, alA, MLO(mA), MHI(mA));
    SLOAD(SO, KVBLK); if constexpr (SDEPTH == 2) { if (2 < NT) SLOAD(SE, 2 * KVBLK); }
    SWAIT(); SWRITE(1, SO); mB = sr_[SO].mk; __syncthreads();
    for (int j = 1; j + 1 < NT; j += 2) {
        SBAR(); initSM(pB0, pB1, m_reg, tp0 + j * KVBLK); QKT(pB0, pB1, K_lds + SHM_K);
        finishSM(pA0, pA1, alA, l_reg, pa0, pa1, pa2, pa3); SBAR();
        SLOAD(SO, (j + SDEPTH) * KVBLK); SBAR();
        pv_d0(o, vb0, pa0, pa1, pa2, pa3); partialSM(pB0, pB1, m_reg, alB, MLO(mB), MHI(mB));
        __syncthreads(); SWAIT(); SWRITE(0, SE); mA = sr_[SE].mk;
        RESC(alB); __syncthreads();
        SBAR(); initSM(pA0, pA1, m_reg, tp0 + (j + 1) * KVBLK); QKT(pA0, pA1, K_lds);
        finishSM(pB0, pB1, alB, l_reg, pa0, pa1, pa2, pa3); SBAR();
        if (SDEPTH == 1 || j + 3 < NT) SLOAD(SE, (j + 1 + SDEPTH) * KVBLK); SBAR();
        pv_d0(o, vb0 + SHM_V, pa0, pa1, pa2, pa3); partialSM(pA0, pA1, m_reg, alA, MLO(mA), MHI(mA));
        __syncthreads(); SWAIT(); SWRITE(1, SO); mB = sr_[SO].mk;
        RESC(alA); __syncthreads();
    }
    SBAR(); initSM(pB0, pB1, m_reg, tp0 + (NT - 1) * KVBLK); QKT(pB0, pB1, K_lds + SHM_K);
    finishSM(pA0, pA1, alA, l_reg, pa0, pa1, pa2, pa3); SBAR();
    pv_d0(o, vb0, pa0, pa1, pa2, pa3); partialSM(pB0, pB1, m_reg, alB, MLO(mB), MHI(mB));
    __syncthreads(); RESC(alB);
    finishSM(pB0, pB1, alB, l_reg, pa0, pa1, pa2, pa3); SBAR();
    pv_d0(o, vb0 + SHM_V, pa0, pa1, pa2, pa3);
    __builtin_amdgcn_s_setprio(0);
    if (hi == 0) li_l[r32] = l_reg; asm volatile("s_waitcnt lgkmcnt(0)" ::: "memory");
    LAS unsigned char* st = lds + QS_OFF + wid * QS_WAVE;
    int le = lane; asm volatile("" : "+v"(le)); const int r32e = le & 31, hie = le >> 5;
#pragma unroll
    for (int r = 0; r < 16; ++r) { const float rl = __builtin_amdgcn_rcpf(li_l[crow(r, hie)]) * O8_SCALE; LAS unsigned char* rowp = st + crow(r, hie) * 128 + r32e;
#pragma unroll
        for (int d0 = 0; d0 < 4; ++d0) { const float x = o[d0][r] * rl; rowp[32 * d0] = (unsigned char)__builtin_amdgcn_cvt_pk_fp8_f32(x, x, 0, false); } }
    asm volatile("s_waitcnt lgkmcnt(0)" ::: "memory");
    unsigned char* Ow = Ob + (long)(wid * 32) * LDO;
#pragma unroll
    for (int i = 0; i < 4; ++i) { const int row = (le >> 3) + 8 * i; const v4u v = *(const LAS v4u*)(st + row * 128 + (le & 7) * 16); *(v4u*)(Ow + (long)row * LDO + (le & 7) * 16) = v; }
    asm volatile("s_waitcnt lgkmcnt(0)" ::: "memory");
#undef SLOAD
#undef SWRITE
#undef SWAIT
#undef RESC
#undef MLO
#undef QKT
#undef MHI
}
}
struct Args { const float* in[13]; float* out; unsigned char* ws; int ph_lo, ph_hi, grid, pad; };
__global__ void __launch_bounds__(NWAVES * 64, 2) fwd(Args args) {
    extern __shared__ __attribute__((aligned(16))) unsigned char lds_raw[];
    Frame F;
    F.lds = (LAS unsigned char*)lds_raw;
    F.MISC = (volatile LAS unsigned*)(F.lds + MISC_OFF);
    F.tid = threadIdx.x; F.lane = F.tid & 63; F.wave = __builtin_amdgcn_readfirstlane(F.tid >> 6);
#define KA(A_) const __attribute__((address_space(4))) Args* A_ = (const __attribute__((address_space(4))) Args*)__builtin_amdgcn_kernarg_segment_ptr(); asm volatile("" : "+s"(A_))
    int lo, hi;
#define FRAME() do { KA(Af_); F.ctl = (gu32*)(Af_->ws + WS_CTL); lo = Af_->ph_lo; hi = Af_->ph_hi; F.lds = (LAS unsigned char*)lds_raw; F.MISC = (volatile LAS unsigned*)(F.lds + MISC_OFF); \
        F.tid = threadIdx.x; asm volatile("" : "+v"(F.tid)); F.lane = F.tid & 63; F.wave = __builtin_amdgcn_readfirstlane(F.tid >> 6); F.G = Af_->grid; { const int bx = blockIdx.x; F.vcu = (F.G % 8 == 0) ? (bx % 8) * (F.G / 8) + bx / 8 : bx; } } while (0)
    FRAME();
    for (int u = F.tid; u < (LDS_BYTES - LDSCTL_OFF) / 4; u += NWAVES * 64) ((LAS unsigned*)(F.lds + LDSCTL_OFF))[u] = 0u;
    __syncthreads();
    if (hi - lo > 1) (void)xcd_barrier_post((unsigned*)(F.ctl + CW_BAR), F.MISC + 8);
#define SEAM(k) do { FRAME(); if (IN(k) && IN((k) + 1)) { XcdBarrier bar_; bar_.bar = (unsigned*)(F.ctl + CW_BAR); bar_.x = xb_xcc_id(); bar_.G = (unsigned)F.G; bar_.st = F.MISC + 8; xcd_barrier(bar_); } } while (0)
#ifdef PH_ONLY
#define IN(k) ((k) == PH_ONLY && lo <= (k) && (k) < hi)
#else
#define IN(k) (lo <= (k) && (k) < hi)
#endif

#define P0ARGS(A_, Ap_, ws_) P0Args A_{Ap_->in[0], Ap_->in[1], Ap_->in[2], Ap_->in[6], Ap_->in[7], Ap_->in[8], Ap_->in[9], Ap_->in[10], Ap_->in[11], ws_ + WS_W1Q8, ws_ + WS_W1G8, (bf16*)(ws_ + WS_W1I), ws_ + WS_WP8, ws_ + WS_WO8, \
        (bf16*)(ws_ + WS_WU), (bf16*)(ws_ + WS_WD), (bf16*)(ws_ + WS_XB), ws_ + WS_X8, (float*)(ws_ + CTL_RSTD0)}
#define P0_DEFERRED_SLOT(slot_) do { if (((((int)blockIdx.x & 7) * 3) >> 3) == (slot_)) { __syncthreads(); { KA(Ad_); unsigned char* wsd_ = Ad_->ws; P0ARGS(Ad, Ad_, wsd_); FRAME(); p0_prologue<true>(F, Ad); } __syncthreads(); } } while (0)
    FRAME();
    if (IN(0)) {
        KA(Ap); unsigned char* ws = Ap->ws;
        { P0ARGS(A, Ap, ws); p0_prologue<false>(F, A); }
        SEAM(0);
    }
    FRAME();
    if (IN(1)) {
        P0_DEFERRED_SLOT(0);
        KA(Ap); unsigned char* ws = Ap->ws;
        const bool bal = (F.G == 256);
        { pg8::Gemm g{(bf16*)(ws + WS_X8), (bf16*)(ws + WS_W1Q8), M, NQKV_W, DM / 2};
          pg8::BalancedOrder S; if (bal) S.init(M, NQKV_W, F.G, (int)blockIdx.x, 6, 192, 2, true); else S.init(M, NQKV_W, F.G, (int)blockIdx.x, 1 << 20, 0, 0, true);
          pg8::EpiQKV E{1.0f / W8_SCALE, (bf16*)(ws + WS_QKV), (bf16*)(ws + WS_KAF), (size_t)(WS_KBF - WS_KAF) / 2, (const float*)(ws + CTL_RSTD0)};
          pg8::gemm_phase<pg8::EpiQKV, pg8::BalancedOrder, true, true, true>(F.lds, g, S, E); }
        __syncthreads();
        P0_DEFERRED_SLOT(1);
        { pg8::Gemm g{(bf16*)(ws + WS_XB), (bf16*)(ws + WS_W1I), M, N1I, DM};
          pg8::BalancedOrder S; if (bal) S.init(M, N1I, F.G, (int)blockIdx.x, 1, 192, 1, false); else S.init(M, N1I, F.G, (int)blockIdx.x, 1 << 20, 0, 0, true);
          typedef pg8::EpiIdx<WS_QI, WS_KI, WS_WI, CTL_RSTD0> EpiIdxT; EpiIdxT E{ws, Ap->in[3], Ap->in[4]};
          pg8::gemm_phase<EpiIdxT, pg8::BalancedOrder, true, true, false>(F.lds, g, S, E); }
        P0_DEFERRED_SLOT(2);
        SEAM(1);
    }
    FRAME();
    if (IN(2)) { }
    FRAME();
    if (IN(3)) {
        KA(Ap); unsigned char* ws = Ap->ws; unsigned char* dob = (unsigned char*)Ap->out;
        const bf16* QKV = (const bf16*)(ws + WS_QKV); const bf16* KAF = (const bf16*)(ws + WS_KAF); const bf16* QI = (const bf16*)(ws + WS_QI); const bf16* KI = (const bf16*)(ws + WS_KI); const float* WI = (const float*)(ws + WS_WI); unsigned* MASK = (unsigned*)(ws + WS_MASK);
        bf16* OAP = (bf16*)(dob + DO_OAP); float* LSE = (float*)(dob + DO_LSE);
        const float* tbl = Ap->in[5];
        LAS float* tabA = (LAS float*)(F.lds + NWAVES * WL_BYTES);
        for (int i = F.tid; i < 12 * TABA_N; i += NWAVES * 64) { const int gh = i / TABA_N, j = i % TABA_N - 32, g = gh >> 2;
            tabA[gh * TABA_N + (TABA_N - 1 - i % TABA_N)] = (j >= 0 && j <= 128) ? tbl[t5_bucket(j << (2 * g)) * 20 + gh] * LOG2E : NEGV; }
        __syncthreads();
        const int gw = F.vcu * NWAVES + F.wave, NGW = F.G * NWAVES;
#pragma unroll 1
        for (int st = 0; st < 2; ++st) { const bool do_idx = (st == 0);
        if (do_idx) {
        for (int i = gw, j = 0; i < BATCH * (SEQ / 2); i += NGW, ++j) { const int b = i / (SEQ / 2), pi = i % (SEQ / 2); const int pr = (j & 1) ? (SEQ / 2 - 1 - pi) : pi;
            index_unit(QI, KI, WI, MASK, b, 2 * pr, F.lane); }
        } else {
        for (int i = gw; i < BATCH * 3 * 4 * 64; i += NGW) { const int u = i & 63, h = (i >> 6) & 3, g = (i >> 8) % 3, b = (i >> 8) / 3;
            const int nblk = (SEQ >> (2 * g)) / 32;
            const size_t tb = (size_t)b * SEQ; const int col = g * 512 + h * 128, p0 = (u % nblk) * 32, r = u / nblk;
            WUnit<0> U{QKV + tb * NQKV + col, KAF + ((size_t)(((b * 3 + g) * 4 + h) * 64 + r * nblk)) * 4096, QKV + tb * NQKV + 1536 + col, 2 * g, r, p0, tabA + (g * 4 + h) * TABA_N, nullptr, F.lds + F.wave * WL_BYTES, F.lane};
            wu_run<0>(U, p0 >= 128 ? p0 - 128 : 0, false, OAP + ((size_t)g * M + tb) * 512 + h * 128, 512, LSE + ((size_t)g * M + tb) * 4 + h); }
        } }
        VM_WAIT(); __syncthreads();
        SEAM(3);
    }
    FRAME();
    if (IN(4)) {
        KA(Ap); unsigned char* ws = Ap->ws; unsigned char* dob = (unsigned char*)Ap->out;
        const bf16* QKV = (const bf16*)(ws + WS_QKV); const bf16* KBF = (const bf16*)(ws + WS_KBF); const unsigned* MASK = (const unsigned*)(ws + WS_MASK);
        const bf16* OAP = (const bf16*)(dob + DO_OAP); const float* LSE = (const float*)(dob + DO_LSE); unsigned char* OAB = dob + DO_OAB;
        for (int pc = (int)blockIdx.x * (NWAVES * 64) + F.tid; pc < M * 64; pc += F.G * NWAVES * 64) { const int tok = pc >> 6, hh = (pc >> 4) & 3, c = (pc & 15) * 8;
            const float l0 = LSE[(size_t)tok * 4 + hh], l1 = LSE[((size_t)M + tok) * 4 + hh], l2 = LSE[((size_t)2 * M + tok) * 4 + hh];
            const float mx = fmaxf(l0, fmaxf(l1, l2)); float w0 = __builtin_amdgcn_exp2f(l0 - mx), w1 = __builtin_amdgcn_exp2f(l1 - mx), w2 = __builtin_amdgcn_exp2f(l2 - mx);
            const float inv = 1.0f / (w0 + w1 + w2); w0 *= inv; w1 *= inv; w2 *= inv;
            const size_t off = (size_t)tok * 512 + hh * 128 + c;
            const v4u a = *(const v4u*)(OAP + off), bq = *(const v4u*)(OAP + (size_t)M * 512 + off), cq = *(const v4u*)(OAP + (size_t)2 * M * 512 + off);
            f32x4 a0, a1, b0, b1, c0, c1; pg8::unpack8(a, a0, a1); pg8::unpack8(bq, b0, b1); pg8::unpack8(cq, c0, c1);
            const f32x4 r0 = (a0 * w0 + b0 * w1 + c0 * w2) * O8_SCALE, r1 = (a1 * w0 + b1 * w1 + c1 * w2) * O8_SCALE; typedef unsigned u32x2 __attribute__((ext_vector_type(2)));
            *(u32x2*)(OAB + (size_t)tok * KP + hh * 128 + c) = (u32x2){pk4_fp8(r0[0], r0[1], r0[2], r0[3]), pk4_fp8(r1[0], r1[1], r1[2], r1[3])}; }
        const float* tbl = Ap->in[5];
        LAS float* tabB = (LAS float*)(F.lds + ab::TABB_OFF);
        for (int u = F.vcu; u < BATCH * 8 * 4; u += F.G) { const int b = u >> 5, h = (u >> 2) & 7, xq = u & 3;
            __syncthreads();
            int ti_ = F.tid; asm volatile("" : "+v"(ti_));
            for (int i = ti_; i < ab::TABD_N; i += NWAVES * 64) { const int dist = i - ab::GUARD; tabB[ab::TABD_N - 1 - i] = dist >= 0 ? tbl[t5_bucket(dist) * 20 + 12 + h] * LOG2E : 0.f; }
            __syncthreads();
            const size_t tb = (size_t)b * SEQ;
#pragma unroll 1
            for (int half = 0; half < 2; ++half) { const int qb = half ? xq : 7 - xq; const size_t row0 = tb + (size_t)qb * 256;
                ab::attnB_block(QKV + row0 * NQKV + 3072 + h * 128, KBF + (size_t)((b * 8 + h) * 64) * 4096, QKV + tb * NQKV + 4096 + h * 128, OAB + row0 * KP + 512 + h * 128,
                                MASK + row0 * 64, qb * 256, 4 * (qb + 1), F.lds);
                __syncthreads(); }
        }
        VM_WAIT(); __syncthreads();
    }
    FRAME();
    if (IN(5)) {
        KA(Ap); unsigned char* ws = Ap->ws; bf16* Rlo = (bf16*)(ws + WS_R_LO); bf16* SBlo = (bf16*)(ws + WS_SB_LO);
        const long r_hi = ((long)WS_R_HI - (long)WS_R_LO) / 2 - (long)(M / 2) * DM, sb_hi = ((long)((uintptr_t)Ap->out + DO_SB_HI) - (long)(uintptr_t)(ws + WS_SB_LO)) / 2 - (long)(M / 2) * DM;
        pg8::Gemm g{(bf16*)(ws + WS_X8), (bf16*)(ws + WS_W1G8), M, NG, DM / 2}; pg8::DenseOrder<16> S; S.init(0, M / 256, F.G, (int)blockIdx.x, 1);
        pg8::EpiGate E{Rlo, SBlo, r_hi, sb_hi, (const float*)(ws + CTL_RSTD0), 1.0f / W8_SCALE};
        pg8::gemm_phase<pg8::EpiGate, pg8::DenseOrder<16>, true, true, true>(F.lds, g, S, E);
        SEAM(5);
    }
    FRAME();
    if (IN(6)) {
        KA(Ap); unsigned char* ws = Ap->ws; bf16* Rlo = (bf16*)(ws + WS_R_LO); bf16* SBlo = (bf16*)(ws + WS_SB_LO);
        const long r_hi = ((long)WS_R_HI - (long)WS_R_LO) / 2 - (long)(M / 2) * DM, sb_hi = ((long)((uintptr_t)Ap->out + DO_SB_HI) - (long)(uintptr_t)(ws + WS_SB_LO)) / 2 - (long)(M / 2) * DM;
        pg8::Gemm g{(bf16*)((unsigned char*)Ap->out + DO_OAB), (bf16*)(ws + WS_WP8), M, DM, KP / 2}; pg8::DenseOrder<8> S; S.init(0, M / 256, F.G, (int)blockIdx.x, 0);
        pg8::EpiMerged<4> E{ws + WS_MG8, Rlo, SBlo, r_hi, sb_hi, O8_SCALE / (O8_SCALE * WP8_SCALE)};
        pg8::gemm_phase<pg8::EpiMerged<4>, pg8::DenseOrder<8>, true, true, true>(F.lds, g, S, E);
        SEAM(6);
    }
    FRAME();
    if (IN(7)) {
        KA(Ap); unsigned char* ws = Ap->ws;
        pg8::Gemm g{(bf16*)(ws + WS_MG8), (bf16*)(ws + WS_WO8), M, DM, DM / 2}; pg8::DenseOrder<8> S; S.init(0, M / 256, F.G, (int)blockIdx.x, 1);
        pg8::EpiResid E{(bf16*)(ws + WS_XB), (float*)(ws + CTL_SS1), 1.0f / (O8_SCALE * W8_SCALE)};
        pg8::gemm_phase<pg8::EpiResid, pg8::DenseOrder<8>, true, true, true>(F.lds, g, S, E);
        SEAM(7);
    }
    FRAME();
    if (IN(8)) {
        KA(Ap); unsigned char* ws = Ap->ws;
        pg8::Gemm g{(bf16*)(ws + WS_XB), (bf16*)(ws + WS_WU), M, DFF, DM}; pg8::WeightStationaryOrder S; S.init(F.G, (int)blockIdx.x, 1);
        pg8::EpiUp E{(bf16*)(ws + WS_H), (const float*)(ws + CTL_SS1)};
        pg8::gemm_phase<pg8::EpiUp, pg8::WeightStationaryOrder, true, true>(F.lds, g, S, E);
        SEAM(8);
    }
    FRAME();
    if (IN(9)) {
        KA(Ap); unsigned char* ws = Ap->ws;
        pg8::Gemm g{(bf16*)(ws + WS_H), (bf16*)(ws + WS_WD), M, DM, DFF}; pg8::DenseOrder<8> S; S.init(0, M / 256, F.G, (int)blockIdx.x, 0);
        pg8::EpiResid E{(bf16*)(ws + WS_XB), (float*)(ws + CTL_SS2), 1.0f};
        pg8::gemm_phase<pg8::EpiResid, pg8::DenseOrder<8>, true, true, false, true>(F.lds, g, S, E);
        SEAM(9);
    }
    FRAME();
    if (IN(10)) {
        KA(Ap); const float* gf = Ap->in[12]; float* outp = Ap->out; const float* ss2 = (const float*)(Ap->ws + CTL_SS2); const bf16* x2b = (const bf16*)(Ap->ws + WS_XB);
        const int gw = F.vcu * NWAVES + F.wave, NGW = F.G * NWAVES;
        f32x4 gv[8];
#pragma unroll
        for (int q = 0; q < 4; ++q) { gv[2 * q] = *((const f32x4*)(gf + 512 * q + 8 * F.lane)); gv[2 * q + 1] = *((const f32x4*)(gf + 512 * q + 8 * F.lane + 4)); }
        for (int m = gw; m < M; m += NGW) { const float rs = 1.0f / sqrtf(ss2[m] * (1.0f / DM) + 1e-6f);
            const GAS v4u* xr = (const GAS v4u*)(x2b + (size_t)m * DM) + F.lane; GAS f32x4* orow = (GAS f32x4*)(outp + (size_t)m * DM) + 2 * F.lane;
            v4u w[4];
#pragma unroll
            for (int q = 0; q < 4; ++q) w[q] = xr[64 * q];
#pragma unroll
            for (int q = 0; q < 4; ++q) { f32x4 a, b; pg8::unpack8(w[q], a, b); orow[128 * q] = a * rs * gv[2 * q]; orow[128 * q + 1] = b * rs * gv[2 * q + 1]; } }
    }
#undef IN
#undef SEAM
}

#ifndef MK_N_LAUNCHES
#define MK_N_LAUNCHES 1
#endif
extern "C" void kernel_launch(void* const* d_in, const int* in_sizes, int n_in, void* d_out, int out_size, void* d_ws, size_t ws_size, hipStream_t stream) {
    static int grid = 0;
    if (grid == 0) {
        if (n_in != 13 || in_sizes[0] != M * DM || out_size != M * DM || ws_size < WS_END) { fprintf(stderr, "kernel_launch: shape/workspace mismatch (n_in %d, in0 %d, out %d, ws %zu; need ws >= %zu); nothing launched\n", n_in, n_in > 0 ? in_sizes[0] : -1, out_size, ws_size, (size_t)WS_END); grid = -1; return; }
        int dev = 0, cus = 0, per_cu = 0;
        if (hipGetDevice(&dev) != hipSuccess || hipDeviceGetAttribute(&cus, hipDeviceAttributeMultiprocessorCount, dev) != hipSuccess) { fprintf(stderr, "kernel_launch: device query failed\n"); grid = -1; return; }
        if (hipFuncSetAttribute((const void*)fwd, hipFuncAttributeMaxDynamicSharedMemorySize, LDS_BYTES) != hipSuccess) { fprintf(stderr, "kernel_launch: hipFuncSetAttribute(%d B LDS) failed\n", LDS_BYTES); grid = -1; return; }
        if (hipOccupancyMaxActiveBlocksPerMultiprocessor(&per_cu, (const void*)fwd, NWAVES * 64, LDS_BYTES) != hipSuccess || per_cu < 1) { fprintf(stderr, "kernel_launch: occupancy query reports %d workgroups per CU\n", per_cu); }
        (void)hipGetLastError();
        grid = cus;
    }
    if (grid < 0) return;
    if (hipMemsetAsync((char*)d_ws + WS_CTL, 0, CTL_ZERO_BYTES, stream) != hipSuccess) { fprintf(stderr, "kernel_launch: memset failed\n"); return; }
    Args a{};
    for (int i = 0; i < 13; ++i) a.in[i] = (const float*)d_in[i];
    a.out = (float*)d_out; a.ws = (unsigned char*)d_ws; a.grid = grid; a.pad = 0;
#if MK_N_LAUNCHES == 1
    a.ph_lo = 0; a.ph_hi = NPH;
    hipLaunchKernelGGL(fwd, dim3(grid), dim3(NWAVES * 64), LDS_BYTES, stream, a);
#else
    for (int p = 0; p < NPH; ++p) { a.ph_lo = p; a.ph_hi = p + 1; hipLaunchKernelGGL(fwd, dim3(grid), dim3(NWAVES * 64), LDS_BYTES, stream, a); }
#endif
    const hipError_t le = hipPeekAtLastError();
    if (le != hipSuccess) fprintf(stderr, "kernel_launch: launch failed: %s\n", hipGetErrorName(le));
}
```
